# Optimizing an MI355X kernel written in HIP

```python
import jax, jax.numpy as jnp
from jax import lax
import numpy as np

D_MODEL = 1024
BATCH = 32
SEQ = 2048
DEPTH = 2

CHUNK = 64
HG_HEADS = 4
HG_DK = 128
HG_DV = 128
HG_WIDTH = HG_HEADS * HG_DK
ML_HEADS = 4
ML_DV = 128
ML_DQK = 64
ML_WIDTH = ML_HEADS * ML_DV
CONV_K = 4
N_BRANCH = 2
IN_SIZES = (HG_WIDTH, HG_WIDTH, HG_WIDTH, HG_WIDTH, ML_WIDTH, ML_WIDTH, ML_WIDTH, ML_HEADS, ML_HEADS, D_MODEL, D_MODEL)
IN_COLS = 4 * HG_WIDTH + 3 * ML_WIDTH + 2 * ML_HEADS + N_BRANCH * D_MODEL
D_FF = 2816
N_EXPERTS = 8
TOP_K = 2
D_FF_EXPERT = 1408
N_DENSE = (DEPTH + 1) // 2
N_MOE = DEPTH // 2
EPS = 1e-6

kernel_name = "hgrn2_mlstm_gated_hybrid_moe"


def rms_norm(x, g):
    xf = x.astype(jnp.float32)
    y = xf * lax.rsqrt(jnp.mean(xf * xf, axis=-1, keepdims=True) + EPS)
    return (y * g.astype(jnp.float32)).astype(x.dtype)


def head_rms_norm(o, g):
    B, S, H, d = o.shape
    y = o * lax.rsqrt(jnp.mean(o * o, axis=-1, keepdims=True) + EPS)
    return y.reshape(B, S, H * d) * g.astype(jnp.float32)


def ada_params(c_act, w, b):
    mod = c_act @ w + b
    shift, scale, gate = jnp.split(mod, 3, axis=-1)
    return shift[:, None, :], scale[:, None, :], gate[:, None, :]


def modulate(h, shift, scale):
    return h * (1 + scale) + shift


def to_chunks(t):
    B, S, H, d = t.shape
    return t.reshape(B, S // CHUNK, CHUNK, H, d).transpose(1, 0, 3, 2, 4)


def from_chunks(t):
    nc, B, H, C, d = t.shape
    return t.transpose(1, 0, 3, 2, 4).reshape(B, nc * C, H, d)


def hgrn2_chunkwise(q, k, v, log_f):
    B, S, H, DK = q.shape
    DV = v.shape[-1]
    qc, kc, vc, lfc = (to_chunks(t.astype(jnp.float32)) for t in (q, k, v, log_f))
    causal = jnp.tril(jnp.ones((CHUNK, CHUNK), dtype=bool))

    def step(state, inp):
        qb, kb, vb, lfb = inp
        A = jnp.cumsum(lfb, axis=2)
        diff = A[:, :, :, None, :] - A[:, :, None, :, :]
        decay = jnp.exp(jnp.where(causal[:, :, None], diff, -jnp.inf))
        scores = jnp.einsum("bhtk,bhsk,bhtsk->bhts", qb, kb, decay)
        o_intra = jnp.einsum("bhts,bhsv->bhtv", scores, vb)
        o_inter = jnp.einsum("bhtk,bhkv->bhtv", qb * jnp.exp(A), state)
        A_last = A[:, :, -1:, :]
        k_dec = kb * jnp.exp(A_last - A)
        new_state = jnp.exp(A_last[:, :, 0, :])[..., None] * state + jnp.einsum("bhsk,bhsv->bhkv", k_dec, vb)
        return new_state, o_intra + o_inter

    s0 = jnp.zeros((B, H, DK, DV), jnp.float32)
    _, o = lax.scan(step, s0, (qc, kc, vc, lfc))
    return from_chunks(o)


def mlstm_chunkwise(q, k, v, i_pre, log_f):
    B, S, H, DQK = q.shape
    DV = v.shape[-1]
    qc, kc, vc = (to_chunks(t.astype(jnp.float32)) for t in (q, k, v))
    ic, fc = (to_chunks(t.astype(jnp.float32)[..., None])[..., 0] for t in (i_pre, log_f))
    causal = jnp.tril(jnp.ones((CHUNK, CHUNK), dtype=bool))

    def step(carry, inp):
        C_prev, n_prev, m_prev = carry
        qb, kb, vb, ib, lfb = inp
        b = jnp.cumsum(lfb, axis=-1)
        d_log = jnp.where(causal, b[..., :, None] - b[..., None, :] + ib[..., None, :], -jnp.inf)
        inter_log = b + m_prev[..., None]
        m_t = jnp.maximum(jnp.max(d_log, axis=-1), inter_log)
        w = jnp.exp(d_log - m_t[..., None])
        w_inter = jnp.exp(inter_log - m_t)
        qk = jnp.einsum("bhtd,bhsd->bhts", qb, kb) * w
        num = jnp.einsum("bhts,bhsv->bhtv", qk, vb) + w_inter[..., None] * jnp.einsum("bhtd,bhdv->bhtv", qb, C_prev)
        den = jnp.sum(qk, axis=-1) + w_inter * jnp.einsum("bhtd,bhd->bht", qb, n_prev)
        h = num / jnp.maximum(jnp.abs(den), jnp.exp(-m_t))[..., None]
        b_last = b[..., -1]
        state_log = b_last[..., None] - b + ib
        m_new = jnp.maximum(b_last + m_prev, jnp.max(state_log, axis=-1))
        w_s = jnp.exp(state_log - m_new[..., None])
        decay_prev = jnp.exp(b_last + m_prev - m_new)
        C_new = decay_prev[..., None, None] * C_prev + jnp.einsum("bhs,bhsd,bhsv->bhdv", w_s, kb, vb)
        n_new = decay_prev[..., None] * n_prev + jnp.einsum("bhs,bhsd->bhd", w_s, kb)
        return (C_new, n_new, m_new), h

    carry0 = (jnp.zeros((B, H, DQK, DV), jnp.float32), jnp.zeros((B, H, DQK), jnp.float32), jnp.zeros((B, H), jnp.float32))
    _, h = lax.scan(step, carry0, (qc, kc, vc, ic, fc))
    return from_chunks(h)


def causal_dwconv(u, w, b):
    S = u.shape[1]
    up = jnp.pad(u, ((0, 0), (CONV_K - 1, 0), (0, 0)))
    y = b + w[0] * up[:, 0:S]
    for j in range(1, CONV_K):
        y = y + w[j] * up[:, j:j + S]
    return y


def hybrid_mixer(h, w_in, lb, hg_norm_g, conv_w, conv_b, wq, wk, fbias, ml_norm_g, w_br_hg, w_br_ml, w_out):
    B, S, _ = h.shape
    proj = h @ w_in
    offs = []
    acc = 0
    for sz in IN_SIZES[:-1]:
        acc += sz
        offs.append(acc)
    hq, hf, hi, hg, mu, mv, mo, mi, mf, ga, gb = jnp.split(proj, offs, axis=-1)

    zf = hf.astype(jnp.float32)
    log_f = jnp.logaddexp(jnp.log(lb), jnp.log1p(-lb) + jax.nn.log_sigmoid(zf))
    k_hg = (1 - lb) * jax.nn.sigmoid(-zf)
    q_hg = jax.nn.silu(hq.astype(jnp.float32))
    hs = lambda t, d: t.reshape(B, S, HG_HEADS, d)
    o_hg = hgrn2_chunkwise(hs(q_hg, HG_DK), hs(k_hg, HG_DK), hs(hi, HG_DV), hs(log_f, HG_DK))
    y_hg = head_rms_norm(o_hg, hg_norm_g) * jax.nn.silu(hg.astype(jnp.float32))

    uc = jax.nn.silu(causal_dwconv(mu, conv_w, conv_b)).reshape(B, S, ML_HEADS, ML_DV)
    q_ml = jnp.einsum("bshd,hde->bshe", uc, wq) * (ML_DQK ** -0.5)
    k_ml = jnp.einsum("bshd,hde->bshe", uc, wk)
    v_ml = mv.reshape(B, S, ML_HEADS, ML_DV)
    log_f_ml = jax.nn.log_sigmoid(mf.astype(jnp.float32) + fbias)
    o_ml = mlstm_chunkwise(q_ml, k_ml, v_ml, mi, log_f_ml)
    y_ml = jax.nn.sigmoid(mo.astype(jnp.float32)) * head_rms_norm(o_ml, ml_norm_g)

    y_hg = y_hg.astype(h.dtype) @ w_br_hg
    y_ml = y_ml.astype(h.dtype) @ w_br_ml
    merged = jax.nn.sigmoid(ga) * y_hg + jax.nn.sigmoid(gb) * y_ml
    return merged @ w_out


def swiglu(h, w1, w3, w2):
    return (jax.nn.silu(h @ w1) * (h @ w3)) @ w2


def moe_swiglu(h, router_w, router_b, w1, w3, w2):
    B, S, D = h.shape
    t = h.reshape(B * S, D)
    logits = (t @ router_w).astype(jnp.float32) + router_b.astype(jnp.float32)
    top_v, top_i = lax.top_k(logits, TOP_K)
    gates = jax.nn.softmax(top_v, axis=-1)
    combine = jnp.sum(jax.nn.one_hot(top_i, N_EXPERTS, dtype=jnp.float32) * gates[..., None], axis=1)
    combine = combine.astype(h.dtype)
    out = combine[:, 0:1] * swiglu(t, w1[0], w3[0], w2[0])
    for e in range(1, N_EXPERTS):
        out = out + combine[:, e:e + 1] * swiglu(t, w1[e], w3[e], w2[e])
    return out.reshape(B, S, D)


def setup_inputs(seed: int = 0) -> dict:
    key = jax.random.key(seed)
    ks = jax.random.split(key, 32)
    D = D_MODEL

    def nrm(k, shape, s):
        return jax.random.normal(k, shape, jnp.float32) * s

    return {
        "x": nrm(ks[0], (BATCH, SEQ, D), 1.0),
        "c": nrm(ks[1], (BATCH, D), 1.0),
        "norm_mix_g": 1.0 + nrm(ks[2], (DEPTH, D), 0.1),
        "ada_mix_w": nrm(ks[3], (DEPTH, D, 3 * D), 0.5 * D ** -0.5),
        "ada_mix_b": nrm(ks[4], (DEPTH, 3 * D), 0.02),
        "w_in": nrm(ks[5], (DEPTH, D, IN_COLS), D ** -0.5),
        "hg_lb_logits": nrm(ks[6], (DEPTH, HG_WIDTH), 1.0),
        "hg_norm_g": 1.0 + nrm(ks[7], (DEPTH, HG_WIDTH), 0.1),
        "ml_conv_w": nrm(ks[8], (DEPTH, CONV_K, ML_WIDTH), CONV_K ** -0.5),
        "ml_conv_b": nrm(ks[9], (DEPTH, ML_WIDTH), 0.02),
        "ml_wq": nrm(ks[10], (DEPTH, ML_HEADS, ML_DV, ML_DQK), ML_DV ** -0.5),
        "ml_wk": nrm(ks[11], (DEPTH, ML_HEADS, ML_DV, ML_DQK), ML_DV ** -0.5),
        "ml_fbias": 3.0 + 3.0 * jax.random.uniform(ks[12], (DEPTH, ML_HEADS), jnp.float32),
        "ml_norm_g": 1.0 + nrm(ks[13], (DEPTH, ML_WIDTH), 0.1),
        "w_br_hg": nrm(ks[14], (DEPTH, HG_WIDTH, D), HG_WIDTH ** -0.5),
        "w_br_ml": nrm(ks[15], (DEPTH, ML_WIDTH, D), ML_WIDTH ** -0.5),
        "w_out": nrm(ks[16], (DEPTH, D, D), D ** -0.5),
        "norm_ffn_g": 1.0 + nrm(ks[17], (DEPTH, D), 0.1),
        "ada_ffn_w": nrm(ks[18], (DEPTH, D, 3 * D), 0.5 * D ** -0.5),
        "ada_ffn_b": nrm(ks[19], (DEPTH, 3 * D), 0.02),
        "ffn_w1": nrm(ks[20], (N_DENSE, D, D_FF), D ** -0.5),
        "ffn_w3": nrm(ks[21], (N_DENSE, D, D_FF), D ** -0.5),
        "ffn_w2": nrm(ks[22], (N_DENSE, D_FF, D), D_FF ** -0.5),
        "moe_router_w": nrm(ks[23], (N_MOE, D, N_EXPERTS), D ** -0.5),
        "moe_router_b": nrm(ks[24], (N_MOE, N_EXPERTS), 0.01),
        "moe_w1": nrm(ks[25], (N_MOE, N_EXPERTS, D, D_FF_EXPERT), D ** -0.5),
        "moe_w3": nrm(ks[26], (N_MOE, N_EXPERTS, D, D_FF_EXPERT), D ** -0.5),
        "moe_w2": nrm(ks[27], (N_MOE, N_EXPERTS, D_FF_EXPERT, D), D_FF_EXPERT ** -0.5),
        "final_norm_g": 1.0 + nrm(ks[28], (D,), 0.1),
    }


def reference(x, c, norm_mix_g, ada_mix_w, ada_mix_b, w_in, hg_lb_logits, hg_norm_g,
              ml_conv_w, ml_conv_b, ml_wq, ml_wk, ml_fbias, ml_norm_g, w_br_hg, w_br_ml, w_out,
              norm_ffn_g, ada_ffn_w, ada_ffn_b, ffn_w1, ffn_w3, ffn_w2,
              moe_router_w, moe_router_b, moe_w1, moe_w3, moe_w2, final_norm_g):
    c_act = jax.nn.silu(c)
    lb_all = jnp.cumsum(jax.nn.softmax(hg_lb_logits.astype(jnp.float32), axis=0), axis=0)
    lb_all = lb_all - lb_all[0:1]
    for l in range(DEPTH):
        shift, scale, gate = ada_params(c_act, ada_mix_w[l], ada_mix_b[l])
        h = modulate(rms_norm(x, norm_mix_g[l]), shift, scale)
        mix = hybrid_mixer(h, w_in[l], lb_all[l], hg_norm_g[l], ml_conv_w[l], ml_conv_b[l],
                           ml_wq[l], ml_wk[l], ml_fbias[l], ml_norm_g[l], w_br_hg[l], w_br_ml[l], w_out[l])
        x = x + gate * mix
        shift, scale, gate = ada_params(c_act, ada_ffn_w[l], ada_ffn_b[l])
        h = modulate(rms_norm(x, norm_ffn_g[l]), shift, scale)
        j = l // 2
        if l % 2 == 0:
            ff = swiglu(h, ffn_w1[j], ffn_w3[j], ffn_w2[j])
        else:
            ff = moe_swiglu(h, moe_router_w[j], moe_router_b[j], moe_w1[j], moe_w3[j], moe_w2[j])
        x = x + gate * ff
    return rms_norm(x, final_norm_g)
```

```cpp
#include <hip/hip_runtime.h>
#include <stdint.h>
#include <stddef.h>
#include <string.h>
#define LAS3 __attribute__((address_space(3)))

typedef unsigned short bf16_t;
#define DEVI __device__ __forceinline__

constexpr int D_MODEL = 1024, BATCH = 32, SEQL = 2048, TOK = BATCH * SEQL;
constexpr int IN_COLS = 5640;
constexpr int D_FF = 2816, N_EXP = 8, D_FFE = 1408;
constexpr float EPS = 1e-6f;
constexpr int MOE_ROWS = 2 * TOK + N_EXP * 256;

constexpr size_t MiB = 1024ull * 1024ull;
constexpr size_t OFF_MISC = 0;
constexpr size_t OFF_MOD = OFF_MISC + 64 * 1024;
constexpr size_t OFF_GATES = OFF_MISC + 2 * MiB;
constexpr size_t OFF_RIDX = OFF_MISC + 4 * MiB;
constexpr size_t OFF_RGATE = OFF_MISC + 5 * MiB;
constexpr size_t OFF_RRANK = OFF_MISC + 6 * MiB;
constexpr size_t OFF_RPOS = OFF_MISC + 7 * MiB;
constexpr size_t OFF_MOECTL = OFF_MISC + 8 * MiB;
constexpr size_t OFF_WEIGHTS = 16 * MiB;
constexpr size_t OFF_H = OFF_WEIGHTS + 120 * MiB;
constexpr size_t OFF_QM = OFF_H + 128 * MiB;
constexpr size_t OFF_LF = OFF_QM + 128 * MiB;
constexpr size_t OFF_HI = OFF_LF + 128 * MiB;
constexpr size_t OFF_HG = OFF_HI + 64 * MiB;
constexpr size_t OFF_MU = OFF_HG + 64 * MiB;
constexpr size_t OFF_MV = OFF_MU + 64 * MiB;
constexpr size_t OFF_UC = OFF_MV + 64 * MiB;
constexpr size_t OFF_QQ = OFF_UC + 64 * MiB;
constexpr size_t OFF_KK = OFF_QQ + 32 * MiB;
constexpr size_t OFF_END = OFF_KK + 32 * MiB;
constexpr size_t OFF_XB = OFF_UC;
constexpr size_t OFF_GA = OFF_LF;
constexpr size_t OFF_GB = OFF_HI;
constexpr size_t OFF_MERGED = OFF_MU;
constexpr size_t OFF_U = OFF_QM;
constexpr size_t OFF_A2 = OFF_QM;
constexpr size_t OFF_UE = OFF_QM + 260 * MiB;
static_assert(OFF_UE + (size_t)MOE_ROWS * D_FFE * 2 <= OFF_END, "moe overlay");
static_assert(OFF_END <= 1024 * MiB, "ws");

typedef __bf16 nbf16x2 __attribute__((ext_vector_type(2)));
typedef float nf32x2 __attribute__((ext_vector_type(2)));
DEVI unsigned cvt2bf(float lo, float hi) { nf32x2 f = {lo, hi}; return __builtin_bit_cast(unsigned, __builtin_convertvector(f, nbf16x2)); }
DEVI bf16_t f2bf(float f) { return (bf16_t)(cvt2bf(f, 0.f) & 0xffffu); }
DEVI float bf2f(bf16_t b) { return __uint_as_float(((unsigned)b) << 16); }
DEVI float sigmoidf_(float z) { return __builtin_amdgcn_rcpf(1.0f + __expf(-z)); }
DEVI float siluf_(float z) { return z * __builtin_amdgcn_rcpf(1.0f + __expf(-z)); }
template <int CTRL, int ROWMASK> DEVI float dpp_mov(float old, float v) { return __int_as_float(__builtin_amdgcn_update_dpp(__float_as_int(old), __float_as_int(v), CTRL, ROWMASK, 0xf, false)); }
DEVI float wave_sum(float v) {
    v += dpp_mov<0xB1, 0xf>(0.f, v);
    v += dpp_mov<0x4E, 0xf>(0.f, v);
    v += dpp_mov<0x141, 0xf>(0.f, v);
    v += dpp_mov<0x140, 0xf>(0.f, v);
    v += dpp_mov<0x142, 0xa>(0.f, v);
    v += dpp_mov<0x143, 0xc>(0.f, v);
    return __int_as_float(__builtin_amdgcn_readlane(__float_as_int(v), 63));
}
DEVI float wave_max(float v) {
    v = fmaxf(v, dpp_mov<0xB1, 0xf>(v, v));
    v = fmaxf(v, dpp_mov<0x4E, 0xf>(v, v));
    v = fmaxf(v, dpp_mov<0x141, 0xf>(v, v));
    v = fmaxf(v, dpp_mov<0x140, 0xf>(v, v));
    v = fmaxf(v, dpp_mov<0x142, 0xa>(v, v));
    v = fmaxf(v, dpp_mov<0x143, 0xc>(v, v));
    return __int_as_float(__builtin_amdgcn_readlane(__float_as_int(v), 63));
}
DEVI float wave_sum8(const float (&x)[8], int lane) {
    const bool b2 = lane & 4, b1 = lane & 2, b0 = lane & 1;
    float r1[4], r2[2];
#pragma unroll
    for (int k = 0; k < 4; ++k) r1[k] = (b2 ? x[4 + k] : x[k]) + dpp_mov<0x141, 0xf>(0.f, b2 ? x[k] : x[4 + k]);
#pragma unroll
    for (int k = 0; k < 2; ++k) r2[k] = (b1 ? r1[2 + k] : r1[k]) + dpp_mov<0x4E, 0xf>(0.f, b1 ? r1[k] : r1[2 + k]);
    float r = (b0 ? r2[1] : r2[0]) + dpp_mov<0xB1, 0xf>(0.f, b0 ? r2[0] : r2[1]);
    r += dpp_mov<0x128, 0xf>(0.f, r);
    r += __shfl_xor(r, 16); r += __shfl_xor(r, 32);
    return r;
}
DEVI float wave_scan_sum(float v) {
    v += dpp_mov<0x111, 0xf>(0.f, v); v += dpp_mov<0x112, 0xf>(0.f, v); v += dpp_mov<0x114, 0xf>(0.f, v); v += dpp_mov<0x118, 0xf>(0.f, v);
    v += dpp_mov<0x142, 0xa>(0.f, v); v += dpp_mov<0x143, 0xc>(0.f, v);
    return v;
}
DEVI float wave_scan_max(float v) {
    const float ninf = -3.0e38f;
    v = fmaxf(v, dpp_mov<0x111, 0xf>(ninf, v)); v = fmaxf(v, dpp_mov<0x112, 0xf>(ninf, v)); v = fmaxf(v, dpp_mov<0x114, 0xf>(ninf, v)); v = fmaxf(v, dpp_mov<0x118, 0xf>(ninf, v));
    v = fmaxf(v, dpp_mov<0x142, 0xa>(ninf, v)); v = fmaxf(v, dpp_mov<0x143, 0xc>(ninf, v));
    return v;
}
DEVI float lane63(float v) { return __int_as_float(__builtin_amdgcn_readlane(__float_as_int(v), 63)); }
DEVI unsigned pack_i8x4(float a, float b, float c, float d) {
    const unsigned ua = __float_as_uint(a + 12582912.0f), ub = __float_as_uint(b + 12582912.0f), uc = __float_as_uint(c + 12582912.0f), ud = __float_as_uint(d + 12582912.0f);
    return __builtin_amdgcn_perm(ub, ua, 0x0c0c0400u) | __builtin_amdgcn_perm(ud, uc, 0x04000c0cu);
}
DEVI float sat8(float x) { return __builtin_amdgcn_fmed3f(x, -448.0f, 448.0f); }
DEVI float tof(float v) { return v; }
DEVI float tof(bf16_t v) { return bf2f(v); }

extern __shared__ __attribute__((aligned(16))) unsigned char g_shm[];
constexpr int LDS_WAVETAB = 128 * 1024 + 64;
DEVI unsigned hw_wave_key() { return (unsigned)__builtin_amdgcn_s_getreg((5 << 11) | 4) & 63u; }
DEVI int lane_id_() { return (int)__builtin_amdgcn_mbcnt_hi(~0u, __builtin_amdgcn_mbcnt_lo(~0u, 0u)); }
DEVI int wave_id_() { return __builtin_amdgcn_readfirstlane(((const LAS3 int*)((LAS3 unsigned char*)g_shm + LDS_WAVETAB))[hw_wave_key()]); }
DEVI int tid_() { return wave_id_() * 64 + lane_id_(); }

namespace pg8 {
#define PG8_LAS __attribute__((address_space(3)))
typedef short bf16x8 __attribute__((ext_vector_type(8)));
typedef float f32x4 __attribute__((ext_vector_type(4)));
typedef unsigned u32x4 __attribute__((ext_vector_type(4)));
constexpr int BM = 256, BK = 64, HALF = 128, HTB = HALF * BK * 2, STAGE_BYTES = 8 * HTB, NXCD = 8, WGM = 8;
__host__ __device__ __forceinline__ int lds_byte(int r, int c) { const int st = (r >> 4) * 2 + (c >> 5), rr = r & 15, cc = c & 31, ob = rr * 64 + cc * 2; return st * 1024 + (ob ^ (((ob >> 9) & 1) << 5)); }
__host__ __device__ __forceinline__ void stage_rc(int b, int& R, int& C) { const int st = b / 1024, sb = b % 1024, swz = sb ^ (((sb >> 9) & 1) << 5); R = (st >> 1) * 16 + swz / 64; C = (st & 1) * 32 + (swz % 64) / 2; }
__host__ __device__ __forceinline__ int perm32(int rho) { const int n = rho >> 4, i = rho & 15; return 8 * (i >> 2) + 4 * n + (i & 3); }
struct Unit { int pm, pn, acol; };
struct Gemm { const bf16_t* A; const bf16_t* Bt; int K, lda; const float* rs = nullptr; const float* ws0 = nullptr; const float* ws1 = nullptr; };
struct StaticOrder {
    int nM, nN, nwg, G, c;
    __device__ void init(int M, int N, int G_, int c_) { nM = M / BM; nN = N / BM; nwg = nM * nN; G = G_; c = c_; }
    __device__ bool next(int i, Unit& u) const {
        const long L = (long)i * G + c; if (L >= nwg) return false;
        int wgid = (int)L; { const int q = nwg / NXCD, r = nwg % NXCD, xcd = wgid % NXCD, off = wgid / NXCD; wgid = (xcd < r ? xcd * (q + 1) : r * (q + 1) + (xcd - r) * q) + off; }
        const int nig = WGM * nN, gid = wgid / nig, fm = gid * WGM, gsz = (nM - fm) < WGM ? (nM - fm) : WGM;
        u.pm = fm + ((wgid % nig) % gsz); u.pn = (wgid % nig) / gsz; u.acol = 0; return true;
    }
};
struct BrOrder : StaticOrder {
    __device__ bool next(int i, Unit& u) const { if (!StaticOrder::next(i >> 1, u)) return false; if (i & 1) { u.pn += 8; u.acol = 1024; } return true; }
};
struct MoeOrder {
    const int* ctl; int nN, G, c;
    __device__ bool next(int i, Unit& u) const {
        const int nt = __builtin_amdgcn_readfirstlane(ctl[128]); const long L = (long)i * G + c; if (L >= (long)nt * nN) return false;
        const int pm = (int)(L / nN), pnl = (int)(L % nN); u.pm = pm; u.pn = __builtin_amdgcn_readfirstlane(ctl[4096 + pm]) * nN + pnl; u.acol = 0; return true;
    }
};
__device__ __forceinline__ unsigned cvt_pk_bf16(float lo, float hi) { return cvt2bf(lo, hi); }
__device__ __forceinline__ u32x4 pack8(const f32x4 a, const f32x4 b) { u32x4 w; w.x = cvt_pk_bf16(a[0], a[1]); w.y = cvt_pk_bf16(a[2], a[3]); w.z = cvt_pk_bf16(b[0], b[1]); w.w = cvt_pk_bf16(b[2], b[3]); return w; }
__device__ __forceinline__ void unpack8(const u32x4 w, f32x4& a, f32x4& b) {
    a[0] = __uint_as_float(w.x << 16); a[1] = __uint_as_float(w.x & 0xffff0000u); a[2] = __uint_as_float(w.y << 16); a[3] = __uint_as_float(w.y & 0xffff0000u);
    b[0] = __uint_as_float(w.z << 16); b[1] = __uint_as_float(w.z & 0xffff0000u); b[2] = __uint_as_float(w.w << 16); b[3] = __uint_as_float(w.w & 0xffff0000u); }

typedef int i32x4 __attribute__((ext_vector_type(4)));
typedef int i32x8 __attribute__((ext_vector_type(8)));
__device__ __forceinline__ i32x8 cat8(bf16x8 lo, bf16x8 hi) { return __builtin_shufflevector(__builtin_bit_cast(i32x4, lo), __builtin_bit_cast(i32x4, hi), 0, 1, 2, 3, 4, 5, 6, 7); }
__device__ __forceinline__ const char* uni(const char* p) { unsigned long long v = (unsigned long long)p; asm volatile("" : "+s"(v)); return (const char*)v; }
template <class Epi, class Sched, int FMT = 0>
__device__ __forceinline__ void gemm_phase(PG8_LAS unsigned char* lds, const Gemm g, const Sched& S, const Epi& E) {
    constexpr bool FP8 = (FMT == 1);
    const int tid = tid_(), wid = __builtin_amdgcn_readfirstlane(tid >> 6), lane = tid & 63, wr = wid >> 2, wc = wid & 3, fr = lane & 15, fq = lane >> 4;
    const int K = g.K, nt = K / BK, lda = g.lda;
    unsigned voffA[2], voffB[2];
#pragma unroll
    for (int i = 0; i < 2; ++i) { int R, C; stage_rc(tid * 16 + i * 8192, R, C); const int Rb = Epi::PERM ? ((R & ~31) + perm32(R & 31)) : R;
        voffA[i] = (unsigned)(R * lda + C) * 2u; voffB[i] = (unsigned)(Rb * K + C) * 2u; }
    constexpr unsigned kstep = (unsigned)(BK * 2);
    const unsigned hstepA = (unsigned)HALF * (unsigned)lda * 2u, hstepB = (unsigned)HALF * (unsigned)K * 2u;
    const size_t tstepA = 2 * (size_t)hstepA, tstepB = 2 * (size_t)hstepB;
    const unsigned ldsw = (unsigned)wid * 1024u;
    const int aoff = lds_byte(wr * 64 + fr, fq * 8), boff = lds_byte(wc * 32 + fr, fq * 8);
#define PG8_SA(b, h) (((b) * 2 + (h)) * HTB)
#define PG8_SB(b, h) ((4 + (b) * 2 + (h)) * HTB)
#define PG8_STAGE(bufoff, gbase, voff) do { _Pragma("unroll") for (int _i = 0; _i < 2; ++_i) \
        __builtin_amdgcn_global_load_lds((const unsigned*)((const char*)(gbase) + (voff)[_i]), (PG8_LAS unsigned*)(lds + (bufoff) + ldsw + _i * 8192), 16, 0, 0); } while (0)
#define PG8_LDA(dst, b, h) do { _Pragma("unroll") for (int m = 0; m < 4; ++m) { \
        if constexpr (FP8) dst##8[m] = cat8(*(const PG8_LAS bf16x8*)(lds + PG8_SA(b, h) + aoff + m * 2048), *(const PG8_LAS bf16x8*)(lds + PG8_SA(b, h) + aoff + m * 2048 + 1024)); \
        else { _Pragma("unroll") for (int k = 0; k < 2; ++k) dst[m][k] = *(const PG8_LAS bf16x8*)(lds + PG8_SA(b, h) + aoff + m * 2048 + k * 1024); } } } while (0)
#define PG8_LDB(dst, b, h) do { _Pragma("unroll") for (int n = 0; n < 2; ++n) { \
        if constexpr (FP8) dst##8[n] = cat8(*(const PG8_LAS bf16x8*)(lds + PG8_SB(b, h) + boff + n * 2048), *(const PG8_LAS bf16x8*)(lds + PG8_SB(b, h) + boff + n * 2048 + 1024)); \
        else { _Pragma("unroll") for (int k = 0; k < 2; ++k) dst[n][k] = *(const PG8_LAS bf16x8*)(lds + PG8_SB(b, h) + boff + n * 2048 + k * 1024); } } } while (0)
#define PG8_MMA(ai, bj, At, Bt) do { __builtin_amdgcn_s_setprio(1); _Pragma("unroll") for (int m = 0; m < 4; ++m) _Pragma("unroll") for (int n = 0; n < 2; ++n) { \
        if constexpr (FP8) asm volatile("v_mfma_f32_16x16x128_f8f6f4 %0, %1, %2, %0" : "+v"(acc[ai][bj][m][n]) : "v"(Bt##8[n]), "v"(At##8[m]));   \
        else if constexpr (FMT == 2) { _Pragma("unroll") for (int k = 0; k < 2; ++k) acc[ai][bj][m][n] = __builtin_bit_cast(f32x4, __builtin_amdgcn_mfma_i32_16x16x64_i8(__builtin_bit_cast(i32x4, Bt[n][k]), __builtin_bit_cast(i32x4, At[m][k]), __builtin_bit_cast(i32x4, acc[ai][bj][m][n]), 0, 0, 0)); } \
        else { _Pragma("unroll") for (int k = 0; k < 2; ++k) acc[ai][bj][m][n] = __builtin_amdgcn_mfma_f32_16x16x32_bf16(Bt[n][k], At[m][k], acc[ai][bj][m][n], 0, 0, 0); } } \
        __builtin_amdgcn_s_setprio(0); } while (0)
#define PG8_WAIT_V(n) asm volatile("s_waitcnt vmcnt(" #n ")" ::: "memory")
#define PG8_WAIT_L(n) asm volatile("s_waitcnt lgkmcnt(" #n ")" ::: "memory")
#define PG8_BAR __builtin_amdgcn_s_barrier()
#define PG8_SCHED __builtin_amdgcn_sched_barrier(0)
    Unit cur, nxt; int ui = 0;
    if (!S.next(0, cur)) return;
    f32x4 acc[2][2][4][2];
#pragma unroll
    for (int a = 0; a < 2; ++a)
#pragma unroll
        for (int b = 0; b < 2; ++b)
#pragma unroll
            for (int m = 0; m < 4; ++m)
#pragma unroll
                for (int n = 0; n < 2; ++n) acc[a][b][m][n] = (f32x4){0.f, 0.f, 0.f, 0.f};
    bf16x8 At[4][2], B0[2][2], B1[2][2];
    i32x8 At8[4], B08[2], B18[2];
    const char* cA = (const char*)g.A + (size_t)cur.pm * tstepA + cur.acol; const char* cB = (const char*)g.Bt + (size_t)cur.pn * tstepB;
    PG8_STAGE(PG8_SB(0, 0), cB, voffB); PG8_STAGE(PG8_SA(0, 0), cA, voffA); PG8_STAGE(PG8_SB(0, 1), cB + hstepB, voffB); PG8_STAGE(PG8_SA(0, 1), cA + hstepA, voffA);
    if (wr == 1) PG8_BAR;
    PG8_WAIT_V(4); PG8_BAR;
    PG8_STAGE(PG8_SB(1, 0), cB + kstep, voffB); PG8_STAGE(PG8_SA(1, 0), cA + kstep, voffA); PG8_STAGE(PG8_SB(1, 1), cB + hstepB + kstep, voffB);
    PG8_WAIT_V(6); PG8_BAR;
    for (;;) {
        const bool has_next = S.next(ui + 1, nxt);
        const char* nA = has_next ? (const char*)g.A + (size_t)nxt.pm * tstepA + nxt.acol : cA; const char* nB = has_next ? (const char*)g.Bt + (size_t)nxt.pn * tstepB : cB;
#pragma unroll 1
        for (int t = 0; t < nt; t += 2) {
            const bool last = (t == nt - 2);
            const char* a1 = uni(cA + (size_t)(t + 1) * kstep);
            const char* a2 = uni(last ? nA : cA + (size_t)(t + 2) * kstep); const char* b2 = uni(last ? nB : cB + (size_t)(t + 2) * kstep);
            const char* a3 = a2 + kstep; const char* b3 = b2 + kstep;
            PG8_LDB(B0, 0, 0); PG8_SCHED; PG8_LDA(At, 0, 0); PG8_STAGE(PG8_SA(1, 1), a1 + hstepA, voffA);
            PG8_WAIT_L(8); PG8_BAR; PG8_WAIT_L(0); PG8_MMA(0, 0, At, B0); PG8_BAR; PG8_SCHED;
            PG8_LDB(B1, 0, 1); PG8_STAGE(PG8_SB(0, 0), b2, voffB);
            PG8_BAR; PG8_WAIT_L(0); PG8_MMA(0, 1, At, B1); PG8_BAR;
            PG8_LDA(At, 0, 1); PG8_STAGE(PG8_SA(0, 0), a2, voffA);
            PG8_BAR; PG8_WAIT_L(0); PG8_MMA(1, 0, At, B0); PG8_BAR; PG8_SCHED;
            PG8_STAGE(PG8_SB(0, 1), b2 + hstepB, voffB);
            PG8_WAIT_V(6); PG8_BAR; PG8_MMA(1, 1, At, B1); PG8_BAR;
            PG8_LDB(B0, 1, 0); PG8_SCHED; PG8_LDA(At, 1, 0); PG8_STAGE(PG8_SA(0, 1), a2 + hstepA, voffA);
            PG8_WAIT_L(8); PG8_BAR; PG8_WAIT_L(0); PG8_MMA(0, 0, At, B0); PG8_BAR; PG8_SCHED;
            PG8_LDB(B1, 1, 1); PG8_STAGE(PG8_SB(1, 0), b3, voffB);
            PG8_BAR; PG8_WAIT_L(0); PG8_MMA(0, 1, At, B1); PG8_BAR;
            PG8_LDA(At, 1, 1); PG8_STAGE(PG8_SA(1, 0), a3, voffA);
            PG8_BAR; PG8_WAIT_L(0); PG8_MMA(1, 0, At, B0); PG8_BAR; PG8_SCHED;
            PG8_STAGE(PG8_SB(1, 1), b3 + hstepB, voffB);
            PG8_WAIT_V(6); PG8_BAR; PG8_MMA(1, 1, At, B1); PG8_BAR;
        }
        if constexpr (FP8) asm volatile("s_nop 15\n\ts_nop 15" ::: "memory");
        if constexpr (FMT == 2) {
            const float w0 = *g.ws0, w1 = *g.ws1;
#pragma unroll
            for (int a = 0; a < 2; ++a)
#pragma unroll
                for (int m = 0; m < 4; ++m) { const float r = g.rs[(size_t)cur.pm * BM + a * HALF + wr * 64 + m * 16 + fr]; const float s0 = r * w0, s1 = r * w1;
#pragma unroll
                    for (int n = 0; n < 2; ++n)
#pragma unroll
                        for (int j = 0; j < 4; ++j) { acc[a][0][m][n][j] = (float)__float_as_int(acc[a][0][m][n][j]) * s0; acc[a][1][m][n][j] = (float)__float_as_int(acc[a][1][m][n][j]) * s1; } }
        }
        E(acc, cur, wr, wc, fr, fq);
        if (!has_next) break;
        bool keep = false; if constexpr (Epi::KEEP) keep = E.keep(cur);
        if (!keep)
#pragma unroll
        for (int a = 0; a < 2; ++a)
#pragma unroll
            for (int b = 0; b < 2; ++b)
#pragma unroll
                for (int m = 0; m < 4; ++m)
#pragma unroll
                    for (int n = 0; n < 2; ++n) acc[a][b][m][n] = (f32x4){0.f, 0.f, 0.f, 0.f};
        cur = nxt; cA = nA; cB = nB; ++ui;
    }
    PG8_WAIT_V(0);
    if (wr == 0) PG8_BAR;
    PG8_BAR;
#undef PG8_SA
#undef PG8_SB
#undef PG8_STAGE
#undef PG8_LDA
#undef PG8_LDB
#undef PG8_MMA
#undef PG8_WAIT_V
#undef PG8_WAIT_L
#undef PG8_BAR
#undef PG8_SCHED
}

#define EPI_LOOP_AM _Pragma("unroll") for (int ai = 0; ai < 2; ++ai) _Pragma("unroll") for (int m = 0; m < 4; ++m)
__device__ __forceinline__ f32x4 silu4(f32x4 v) { f32x4 o; _Pragma("unroll") for (int j = 0; j < 4; ++j) o[j] = v[j] * __builtin_amdgcn_rcpf(1.0f + __expf(-v[j])); return o; }
__device__ __forceinline__ f32x4 sigm4(f32x4 v) { f32x4 o; _Pragma("unroll") for (int j = 0; j < 4; ++j) o[j] = __builtin_amdgcn_rcpf(1.0f + __expf(-v[j])); return o; }
struct FEpiWinA {
    static constexpr bool PERM = true, KEEP = false;
    bf16_t* QM; float* LF; bf16_t* HI; bf16_t* HG; bf16_t* MU; bf16_t* MV; const float* lb; float sc;
    __device__ __forceinline__ void operator()(const f32x4 (&acc)[2][2][4][2], const Unit& u, int wr, int wc, int fr, int fq) const {
        const int row0 = u.pm * BM + wr * 64 + fr, grp = u.pn >> 1, cb = (u.pn & 1) * 256 + wc * 32 + 8 * fq;
        if (grp == 1) {
            f32x4 l0[2], l1[2];
#pragma unroll
            for (int bj = 0; bj < 2; ++bj) { l0[bj] = *(const f32x4*)(lb + cb + bj * HALF); l1[bj] = *(const f32x4*)(lb + cb + bj * HALF + 4); }
            EPI_LOOP_AM { float* rp = LF + (size_t)(row0 + ai * HALF + m * 16) * 512 + cb;
#pragma unroll
                for (int bj = 0; bj < 2; ++bj) { f32x4 o0, o1;
#pragma unroll
                    for (int j = 0; j < 4; ++j) { const float z0 = fmaxf(acc[ai][bj][m][0][j] * sc, -80.f), z1 = fmaxf(acc[ai][bj][m][1][j] * sc, -80.f);
                        o0[j] = __logf(l0[bj][j] + (1.f - l0[bj][j]) * __builtin_amdgcn_rcpf(1.0f + __expf(-z0))); o1[j] = __logf(l1[bj][j] + (1.f - l1[bj][j]) * __builtin_amdgcn_rcpf(1.0f + __expf(-z1))); }
                    __builtin_nontemporal_store(o0, (f32x4*)(rp + bj * HALF)); __builtin_nontemporal_store(o1, (f32x4*)(rp + bj * HALF + 4)); } }
        } else if (grp == 0 || grp == 6) {
            bf16_t* base = QM + (grp == 6 ? 512 : 0);
            EPI_LOOP_AM { bf16_t* rp = base + (size_t)(row0 + ai * HALF + m * 16) * 1024 + cb;
#pragma unroll
                for (int bj = 0; bj < 2; ++bj) { const f32x4 a = acc[ai][bj][m][0] * sc, b = acc[ai][bj][m][1] * sc;
                    __builtin_nontemporal_store((grp == 0) ? pack8(silu4(a), silu4(b)) : pack8(sigm4(a), sigm4(b)), (u32x4*)(rp + bj * HALF)); } }
        } else {
            bf16_t* base = (grp == 2) ? HI : (grp == 3) ? HG : (grp == 4) ? MU : MV;
            EPI_LOOP_AM { bf16_t* rp = base + (size_t)(row0 + ai * HALF + m * 16) * 512 + cb;
#pragma unroll
                for (int bj = 0; bj < 2; ++bj) { const f32x4 a = acc[ai][bj][m][0] * sc, b = acc[ai][bj][m][1] * sc;
                    __builtin_nontemporal_store((grp == 3) ? pack8(silu4(a), silu4(b)) : pack8(a, b), (u32x4*)(rp + bj * HALF)); } }
        }
    }
};
struct FEpiWinG {
    static constexpr bool PERM = true, KEEP = false;
    bf16_t* GA; bf16_t* GB; float sc;
    __device__ __forceinline__ void operator()(const f32x4 (&acc)[2][2][4][2], const Unit& u, int wr, int wc, int fr, int fq) const {
        const int row0 = u.pm * BM + wr * 64 + fr, cb = (u.pn & 7) * 128 + wc * 32 + 8 * fq;
        EPI_LOOP_AM { const size_t ro = (size_t)(row0 + ai * HALF + m * 16) * 1024 + cb; f32x4 ra[2], sb[2];
#pragma unroll
            for (int n = 0; n < 2; ++n)
#pragma unroll
                for (int j = 0; j < 4; ++j) { const float ea = __expf(-acc[ai][0][m][n][j] * sc), eb = __expf(-acc[ai][1][m][n][j] * sc); const float s = __builtin_amdgcn_rcpf(1.0f + eb); sb[n][j] = s; ra[n][j] = (1.0f + eb) * __builtin_amdgcn_rcpf(1.0f + ea); }
            __builtin_nontemporal_store(pack8(ra[0], ra[1]), (u32x4*)(GA + ro)); __builtin_nontemporal_store(pack8(sb[0], sb[1]), (u32x4*)(GB + ro)); }
    }
};
struct FEpiBrG {
    static constexpr bool PERM = true, KEEP = true;
    const bf16_t* RA; const bf16_t* SB; bf16_t* Mg; bool M8; float msc;
    __device__ __forceinline__ bool keep(const Unit& u) const { return u.pn < 8; }
    __device__ __forceinline__ void operator()(f32x4 (&acc)[2][2][4][2], const Unit& u, int wr, int wc, int fr, int fq) const {
        const bool first = u.pn < 8; const int row0 = u.pm * BM + wr * 64 + fr, cb = (u.pn & 7) * 256 + wc * 32 + 8 * fq; const bf16_t* Gp = first ? RA : SB;
        u32x4 gq[2][4][2];
#pragma unroll
        for (int ai = 0; ai < 2; ++ai)
#pragma unroll
            for (int m = 0; m < 4; ++m)
#pragma unroll
                for (int bj = 0; bj < 2; ++bj) gq[ai][m][bj] = *(const u32x4*)(Gp + (size_t)(row0 + ai * HALF + m * 16) * 1024 + cb + bj * HALF);
#pragma unroll
        for (int ai = 0; ai < 2; ++ai) {
#pragma unroll
            for (int m = 0; m < 4; ++m)
#pragma unroll
                for (int bj = 0; bj < 2; ++bj) { f32x4 g0, g1; unpack8(gq[ai][m][bj], g0, g1); acc[ai][bj][m][0] *= g0; acc[ai][bj][m][1] *= g1;
                    if (!first) {
                        if (M8) { const f32x4 a = acc[ai][bj][m][0] * msc, b = acc[ai][bj][m][1] * msc; unsigned q0 = 0u, q1 = 0u;
                            q0 = __builtin_amdgcn_cvt_pk_fp8_f32(sat8(a[0]), sat8(a[1]), q0, false); q0 = __builtin_amdgcn_cvt_pk_fp8_f32(sat8(a[2]), sat8(a[3]), q0, true);
                            q1 = __builtin_amdgcn_cvt_pk_fp8_f32(sat8(b[0]), sat8(b[1]), q1, false); q1 = __builtin_amdgcn_cvt_pk_fp8_f32(sat8(b[2]), sat8(b[3]), q1, true);
                            *(uint2*)((unsigned char*)Mg + (size_t)(row0 + ai * HALF + m * 16) * 1024 + cb + bj * HALF) = make_uint2(q0, q1); }
                        else __builtin_nontemporal_store(pack8(acc[ai][bj][m][0], acc[ai][bj][m][1]), (u32x4*)(Mg + (size_t)(row0 + ai * HALF + m * 16) * 1024 + cb + bj * HALF)); } }
        }
    }
};
template <bool XIN_F32> struct FEpiResidT {
    static constexpr bool PERM = true, KEEP = false;
    const void* xin; bf16_t* xout; const float* mod; float sc;
    __device__ __forceinline__ void operator()(const f32x4 (&acc)[2][2][4][2], const Unit& u, int wr, int wc, int fr, int fq) const {
        const int row0 = u.pm * BM + wr * 64 + fr, cb = u.pn * BM + wc * 32 + 8 * fq;
        const float* gp = mod + (size_t)(u.pm >> 3) * 3072 + 2048 + cb;
        f32x4 gv[2][2];
#pragma unroll
        for (int bj = 0; bj < 2; ++bj)
#pragma unroll
            for (int n = 0; n < 2; ++n) gv[bj][n] = *(const f32x4*)(gp + bj * HALF + 4 * n) * sc;
#pragma unroll
        for (int ai = 0; ai < 2; ++ai) {
            f32x4 xv[4][2][2];
#pragma unroll
            for (int m = 0; m < 4; ++m)
#pragma unroll
                for (int bj = 0; bj < 2; ++bj) { const size_t ro = (size_t)(row0 + ai * HALF + m * 16) * 1024 + cb + bj * HALF;
                    if (XIN_F32) { xv[m][bj][0] = *(const f32x4*)((const float*)xin + ro); xv[m][bj][1] = *(const f32x4*)((const float*)xin + ro + 4); }
                    else unpack8(*(const u32x4*)((const bf16_t*)xin + ro), xv[m][bj][0], xv[m][bj][1]); }
#pragma unroll
            for (int m = 0; m < 4; ++m)
#pragma unroll
                for (int bj = 0; bj < 2; ++bj) { const size_t ro = (size_t)(row0 + ai * HALF + m * 16) * 1024 + cb + bj * HALF;
                    __builtin_nontemporal_store(pack8(xv[m][bj][0] + gv[bj][0] * acc[ai][bj][m][0], xv[m][bj][1] + gv[bj][1] * acc[ai][bj][m][1]), (u32x4*)(xout + ro)); }
        }
    }
};
template <bool OUT8> struct FEpiSwigluT {
    static constexpr bool PERM = true, KEEP = false;
    bf16_t* U; int ldu, nN; float sc; int padz;
    __device__ __forceinline__ void operator()(const f32x4 (&acc)[2][2][4][2], const Unit& u, int wr, int wc, int fr, int fq) const {
        const int row0 = u.pm * BM + wr * 64 + fr, pnl = u.pn % nN, cb = pnl * 128 + wc * 32 + 8 * fq;
        EPI_LOOP_AM { const f32x4 o0 = silu4(acc[ai][0][m][0] * sc) * (acc[ai][1][m][0] * sc), o1 = silu4(acc[ai][0][m][1] * sc) * (acc[ai][1][m][1] * sc);
            if (OUT8) { unsigned q0 = 0u, q1 = 0u; q0 = __builtin_amdgcn_cvt_pk_fp8_f32(sat8(o0[0]), sat8(o0[1]), q0, false); q0 = __builtin_amdgcn_cvt_pk_fp8_f32(sat8(o0[2]), sat8(o0[3]), q0, true);
                q1 = __builtin_amdgcn_cvt_pk_fp8_f32(sat8(o1[0]), sat8(o1[1]), q1, false); q1 = __builtin_amdgcn_cvt_pk_fp8_f32(sat8(o1[2]), sat8(o1[3]), q1, true);
                unsigned char* rp = (unsigned char*)U + (size_t)(row0 + ai * HALF + m * 16) * ldu + cb; *(uint2*)rp = make_uint2(q0, q1);
                if (padz && pnl == nN - 1) *(uint2*)(rp + 128) = make_uint2(0u, 0u); }
            else __builtin_nontemporal_store(pack8(o0, o1), (u32x4*)(U + (size_t)(row0 + ai * HALF + m * 16) * ldu + cb)); }
    }
};
typedef FEpiSwigluT<false> FEpiSwiglu;
struct FEpiStoreBf {
    static constexpr bool PERM = true, KEEP = false;
    bf16_t* O; int ldo, nN; float sc;
    __device__ __forceinline__ void operator()(const f32x4 (&acc)[2][2][4][2], const Unit& u, int wr, int wc, int fr, int fq) const {
        const int row0 = u.pm * BM + wr * 64 + fr, cb = (u.pn % nN) * 256 + wc * 32 + 8 * fq;
        EPI_LOOP_AM { bf16_t* rp = O + (size_t)(row0 + ai * HALF + m * 16) * ldo + cb;
#pragma unroll
            for (int bj = 0; bj < 2; ++bj) __builtin_nontemporal_store(pack8(acc[ai][bj][m][0] * sc, acc[ai][bj][m][1] * sc), (u32x4*)(rp + bj * HALF)); }
    }
};
}

struct CvtJob { const float* src; bf16_t* dst; long long src_bstride; int K, ncols, ldsrc, nb, dst_rows_per_batch, mode, tile0, f8, dst_ld, pad; };
static_assert(sizeof(CvtJob) == 64 && offsetof(CvtJob, K) == 24 && offsetof(CvtJob, tile0) == 48 && offsetof(CvtJob, dst_ld) == 56, "CvtJob layout is read word-wise from LDS");
constexpr int N_CVT = 16;
#ifndef DENSE_F8
#define DENSE_F8 0
#endif
#ifndef MOE_F8
#define MOE_F8 1
#endif
#ifndef MOED_F8
#define MOED_F8 1
#endif
constexpr int W2_F8 = 6; constexpr int KD8 = 1536;
static_assert(OFF_UE + (size_t)MOE_ROWS * (MOED_F8 ? (size_t)KD8 : (size_t)D_FFE * 2) <= OFF_XB && OFF_U + (size_t)TOK * D_FF * 2 <= OFF_XB, "FFN overlays must stay below the residual stream");
#ifndef DENSED_F8
#define DENSED_F8 1
#endif
#ifndef WIN1_F8
#define WIN1_F8 1
#endif
constexpr int W13_F8 = 5;
#ifndef OUT_F8
#define OUT_F8 1
#endif
constexpr int OUT_A_SH = 3;
#ifndef USE_I8
#define USE_I8 1
#endif
constexpr int N_I8J = 10;
__host__ __device__ constexpr int i8job(int i) { return i < 6 ? i : (i == 6 ? 9 : (i == 7 ? 10 : (i == 8 ? 12 : 13))); }
constexpr int I8_FLAG = 64;
constexpr float I8_CLIP = 4.0f;
constexpr size_t OFF_WSTEP = OFF_MISC + 9 * MiB;
constexpr size_t OFF_RSH = OFF_MISC + 9 * MiB + 4096;
constexpr size_t OFF_RSE = OFF_MISC + 10 * MiB;
struct CvtJobs { CvtJob j[N_CVT]; int total_tiles; int pad; };
typedef float vf4 __attribute__((ext_vector_type(4)));
constexpr int MT_PITCH = 132;
__device__ __forceinline__ void cvt_mt_load(const CvtJob& jb, int lt, int t, vf4 (&ld)[8]) {
    const int tk = jb.K / 64, tn = jb.ncols / 128, per_b = tk * tn, b = lt / per_b, r = lt % per_b, kt = r / tn, ntile = r % tn;
    const float* sp = jb.src + (size_t)b * jb.src_bstride + (size_t)(kt * 64) * jb.ldsrc + ntile * 128;
    const int r0 = t >> 5, c4 = (t & 31) * 4;
#pragma unroll
    for (int q = 0; q < 8; ++q) ld[q] = *(const vf4*)(sp + (size_t)(r0 + 8 * q) * jb.ldsrc + c4);
}
__device__ __forceinline__ void cvt_mt_lds(int t, const vf4 (&ld)[8], LAS3 float* tile) {
    const int r0 = t >> 5, c4 = (t & 31) * 4;
#pragma unroll
    for (int q = 0; q < 8; ++q) *(LAS3 vf4*)(tile + (r0 + 8 * q) * MT_PITCH + c4) = ld[q];
}
__device__ __forceinline__ void cvt_mt_store(const CvtJob& jb, int lt, int t, const LAS3 float* tile, const LAS3 float* wql) {
    const int tk = jb.K / 64, tn = jb.ncols / 128, per_b = tk * tn, b = lt / per_b, r = lt % per_b, kt = r / tn, ntile = r % tn;
    const int nl = t >> 1, kh = (t & 1) * 32, j = ntile * 128 + nl;
    const int drow = b * jb.dst_rows_per_batch + (jb.mode == 0 ? j : ((j >> 7) * 256 + (j & 127) + (jb.mode == 2 ? 128 : 0)));
    float v[32];
#pragma unroll
    for (int i = 0; i < 32; ++i) v[i] = tile[(kh + i) * MT_PITCH + nl];
    if (jb.f8 >= I8_FLAG) {
        const float qm = wql[jb.pad]; unsigned w[8];
#pragma unroll
        for (int i = 0; i < 8; ++i) w[i] = pack_i8x4(__builtin_amdgcn_fmed3f(v[4 * i] * qm, -127.0f, 127.0f), __builtin_amdgcn_fmed3f(v[4 * i + 1] * qm, -127.0f, 127.0f),
                                                      __builtin_amdgcn_fmed3f(v[4 * i + 2] * qm, -127.0f, 127.0f), __builtin_amdgcn_fmed3f(v[4 * i + 3] * qm, -127.0f, 127.0f));
        uint4* dp = (uint4*)((unsigned char*)jb.dst + (size_t)drow * jb.dst_ld + kt * 64 + kh);
        dp[0] = make_uint4(w[0], w[1], w[2], w[3]); dp[1] = make_uint4(w[4], w[5], w[6], w[7]);
        return; }
    if (jb.f8) {
        const float sc = (float)(1 << jb.f8); unsigned w[8];
#pragma unroll
        for (int i = 0; i < 8; ++i) { unsigned q = 0u;
            q = __builtin_amdgcn_cvt_pk_fp8_f32(sat8(v[4 * i] * sc), sat8(v[4 * i + 1] * sc), q, false);
            q = __builtin_amdgcn_cvt_pk_fp8_f32(sat8(v[4 * i + 2] * sc), sat8(v[4 * i + 3] * sc), q, true); w[i] = q; }
        uint4* dp = (uint4*)((unsigned char*)jb.dst + (size_t)drow * jb.dst_ld + kt * 64 + kh);
        dp[0] = make_uint4(w[0], w[1], w[2], w[3]); dp[1] = make_uint4(w[4], w[5], w[6], w[7]);
        return; }
    unsigned w[16];
#pragma unroll
    for (int i = 0; i < 16; ++i) w[i] = cvt2bf(v[2 * i], v[2 * i + 1]);
    uint4* dp = (uint4*)(jb.dst + (size_t)drow * jb.dst_ld + kt * 64 + kh);
#pragma unroll
    for (int i = 0; i < 4; ++i) dp[i] = make_uint4(w[4 * i], w[4 * i + 1], w[4 * i + 2], w[4 * i + 3]);
}
namespace sc {
typedef short bf16x8 __attribute__((ext_vector_type(8)));
typedef float f32x4 __attribute__((ext_vector_type(4)));
typedef unsigned u32x2 __attribute__((ext_vector_type(2)));
typedef unsigned u32x4v __attribute__((ext_vector_type(4)));
constexpr int PD = 136, PS = 72;
constexpr int SCAN_LDS = 128 * 1024;
DEVI f32x4 mma(bf16x8 x, bf16x8 y, f32x4 c) { return __builtin_amdgcn_mfma_f32_16x16x32_bf16(x, y, c, 0, 0, 0); }
DEVI bf16x8 ldf(const LAS3 bf16_t* base, int pitch, int row, int k0) { return *(const LAS3 bf16x8*)(base + row * pitch + k0); }
DEVI unsigned pk2(float lo, float hi) { return cvt2bf(lo, hi); }
DEVI void st4(LAS3 bf16_t* p, f32x4 v) { u32x2 w; w.x = pk2(v[0], v[1]); w.y = pk2(v[2], v[3]); *(LAS3 u32x2*)p = w; }
DEVI float clampe(float x) { return fminf(fmaxf(x, -80.f), 80.f); }

DEVI void lds_barrier() { asm volatile("s_waitcnt lgkmcnt(0)" ::: "memory"); __builtin_amdgcn_s_barrier(); asm volatile("" ::: "memory"); }
#define SC_FENCE() __builtin_amdgcn_sched_barrier(0)
DEVI void hgrn2_item(LAS3 unsigned char* L, int b, int h, const bf16_t* QM, bf16_t* YO, const float* __restrict__ LF, const bf16_t* __restrict__ HI, const bf16_t* __restrict__ HG, const float* __restrict__ gnorm) {
    LAS3 bf16_t* Qt = (LAS3 bf16_t*)L;
    LAS3 bf16_t* Kt = Qt + 64 * PD;
    LAS3 bf16_t* KtT = Kt + 64 * PD;
    LAS3 bf16_t* VT = KtT + 128 * PS;
    LAS3 bf16_t* Pm = VT + 128 * PS;
    LAS3 bf16_t* ST = Pm + 64 * PS;
    LAS3 float* er = (LAS3 float*)(ST + 128 * PD);
    LAS3 float* ea = er + 128;
    LAS3 float* segs = ea + 128;
    LAS3 float* red = segs + 512;
    LAS3 float* gnl = red + 128;
    const int tid = tid_(), wid = __builtin_amdgcn_readfirstlane(tid >> 6), lane = tid & 63, fr = lane & 15, fq = lane >> 4;
    const int ch = tid & 127, sg = tid >> 7;
    const int tj = wid & 3, hw = wid >> 2;
    f32x4 S[8];
#pragma unroll
    for (int i = 0; i < 8; ++i) S[i] = (f32x4){0.f, 0.f, 0.f, 0.f};
    if (tid < 128) gnl[tid] = gnorm[h * 128 + tid];
    float lfv[16]; bf16_t qv[16], vv[16];
#define HG_LOAD(cc) do { const size_t r0_ = (size_t)b * SEQL + (size_t)(cc) * 64; \
        const float* lp = LF + (r0_ + 16 * sg) * 512 + h * 128 + ch; const bf16_t* qp = QM + (r0_ + 16 * sg) * 1024 + h * 128 + ch; const bf16_t* vp = HI + (r0_ + 16 * sg) * 512 + h * 128 + ch; \
        _Pragma("unroll") for (int i = 0; i < 16; ++i) { lfv[i] = lp[(size_t)i * 512]; qv[i] = qp[(size_t)i * 1024]; vv[i] = vp[(size_t)i * 512]; } } while (0)
    HG_LOAD(0);
    for (int c = 0; c < SEQL / 64; ++c) {
        const size_t row0 = (size_t)b * SEQL + (size_t)c * 64;
        float a[16]; uint2 hgv[4];
        { float run = 0.f;
#pragma unroll
          for (int i = 0; i < 16; ++i) { run += lfv[i]; a[i] = run; }
          segs[sg * 128 + ch] = run; }
#pragma unroll
        for (int q = 0; q < 4; ++q) hgv[q] = *(const uint2*)(HG + (row0 + 16 * tj + fr) * 512 + h * 128 + 16 * (4 * hw + q) + 4 * fq);
        lds_barrier();
        { const float s0 = segs[ch], s1 = segs[128 + ch], s2 = segs[256 + ch], s3 = segs[384 + ch];
          const float off = (sg > 0 ? s0 : 0.f) + (sg > 1 ? s1 : 0.f) + (sg > 2 ? s2 : 0.f), r = s0 + s1, alast = (s0 + s1) + (s2 + s3);
          if (sg == 0) { er[ch] = __expf(fmaxf(r, -80.f)); ea[ch] = __expf(fmaxf(alast - r, -80.f)); }
          unsigned kw[8], vw[8];
#pragma unroll
          for (int i = 0; i < 16; i += 2) {
              const float A0 = off + a[i], A1 = off + a[i + 1];
              const float q0 = bf2f(qv[i]) * __expf(clampe(A0 - r)), q1 = bf2f(qv[i + 1]) * __expf(clampe(A1 - r));
              const float kk0 = 1.0f - __expf(a[i] - (i ? a[i - 1] : 0.f)), kk1 = 1.0f - __expf(a[i + 1] - a[i]);
              const float k0 = kk0 * __expf(clampe(r - A0)), k1 = kk1 * __expf(clampe(r - A1));
              const unsigned kp = pk2(k0, k1);
              Qt[(16 * sg + i) * PD + ch] = f2bf(q0); Qt[(16 * sg + i + 1) * PD + ch] = f2bf(q1);
              Kt[(16 * sg + i) * PD + ch] = (bf16_t)(kp & 0xffffu); Kt[(16 * sg + i + 1) * PD + ch] = (bf16_t)(kp >> 16);
              kw[i >> 1] = kp; vw[i >> 1] = (unsigned)vv[i] | ((unsigned)vv[i + 1] << 16);
          }
          *(LAS3 u32x4v*)(KtT + ch * PS + 16 * sg) = (u32x4v){kw[0], kw[1], kw[2], kw[3]}; *(LAS3 u32x4v*)(KtT + ch * PS + 16 * sg + 8) = (u32x4v){kw[4], kw[5], kw[6], kw[7]};
          *(LAS3 u32x4v*)(VT + ch * PS + 16 * sg) = (u32x4v){vw[0], vw[1], vw[2], vw[3]}; *(LAS3 u32x4v*)(VT + ch * PS + 16 * sg + 8) = (u32x4v){vw[4], vw[5], vw[6], vw[7]}; }
        if (c + 1 < SEQL / 64) HG_LOAD(c + 1);
        lds_barrier();
        { const f32x4 erv = *(const LAS3 f32x4*)(er + 16 * wid + 4 * fq);
#pragma unroll
          for (int vt = 0; vt < 8; ++vt) { S[vt] *= erv; st4(ST + (16 * vt + fr) * PD + 16 * wid + 4 * fq, S[vt]); } }
        { const int ti = wid >> 1; bf16x8 yq1[4], xk1[2][4];
#pragma unroll
          for (int k4 = 0; k4 < 4; ++k4) yq1[k4] = ldf(Qt, PD, 16 * ti + fr, 32 * k4 + 8 * fq);
#pragma unroll
          for (int q2 = 0; q2 < 2; ++q2)
#pragma unroll
              for (int k4 = 0; k4 < 4; ++k4) xk1[q2][k4] = ldf(Kt, PD, 16 * (2 * (wid & 1) + q2) + fr, 32 * k4 + 8 * fq);
          SC_FENCE();
#pragma unroll
          for (int q2 = 0; q2 < 2; ++q2) { const int si = 2 * (wid & 1) + q2; f32x4 acc = (f32x4){0.f, 0.f, 0.f, 0.f};
#pragma unroll
              for (int k4 = 0; k4 < 4; ++k4) acc = mma(xk1[q2][k4], yq1[k4], acc);
              const int t = 16 * ti + fr, s0 = 16 * si + 4 * fq;
#pragma unroll
              for (int j = 0; j < 4; ++j) acc[j] = (s0 + j <= t) ? acc[j] : 0.f;
              st4(Pm + t * PS + s0, acc); } }
        lds_barrier();
        f32x4 O[4];
        { bf16x8 yp[2], yq[4], xv[2][6];
#pragma unroll
          for (int k2 = 0; k2 < 2; ++k2) yp[k2] = ldf(Pm, PS, 16 * tj + fr, 32 * k2 + 8 * fq);
#pragma unroll
          for (int k4 = 0; k4 < 4; ++k4) yq[k4] = ldf(Qt, PD, 16 * tj + fr, 32 * k4 + 8 * fq);
#define HG_LDX(buf, q_) do { const int vi_ = 4 * hw + (q_); _Pragma("unroll") for (int k2 = 0; k2 < 2; ++k2) xv[buf][k2] = ldf(VT, PS, 16 * vi_ + fr, 32 * k2 + 8 * fq); \
              _Pragma("unroll") for (int k4 = 0; k4 < 4; ++k4) xv[buf][2 + k4] = ldf(ST, PD, 16 * vi_ + fr, 32 * k4 + 8 * fq); } while (0)
          HG_LDX(0, 0);
#pragma unroll
          for (int q = 0; q < 4; ++q) { if (q + 1 < 4) HG_LDX((q + 1) & 1, q + 1);
              SC_FENCE();
              f32x4 acc = (f32x4){0.f, 0.f, 0.f, 0.f};
#pragma unroll
              for (int k2 = 0; k2 < 2; ++k2) acc = mma(xv[q & 1][k2], yp[k2], acc);
#pragma unroll
              for (int k4 = 0; k4 < 4; ++k4) acc = mma(xv[q & 1][2 + k4], yq[k4], acc);
              O[q] = acc; SC_FENCE(); }
#undef HG_LDX
        }
        { float ss = 0.f;
#pragma unroll
          for (int q = 0; q < 4; ++q) ss += O[q][0] * O[q][0] + O[q][1] * O[q][1] + O[q][2] * O[q][2] + O[q][3] * O[q][3];
          ss += __shfl_xor(ss, 16); ss += __shfl_xor(ss, 32);
          if (fq == 0) red[hw * 64 + 16 * tj + fr] = ss; }
        { bf16x8 xk[2], yv[2][8];
#pragma unroll
          for (int k2 = 0; k2 < 2; ++k2) xk[k2] = ldf(KtT, PS, 16 * wid + fr, 32 * k2 + 8 * fq);
          const f32x4 eav = *(const LAS3 f32x4*)(ea + 16 * wid + 4 * fq);
#define HG_LDV(buf, v0_) do { _Pragma("unroll") for (int i = 0; i < 4; ++i) _Pragma("unroll") for (int k2 = 0; k2 < 2; ++k2) yv[buf][2 * i + k2] = ldf(VT, PS, 16 * ((v0_) + i) + fr, 32 * k2 + 8 * fq); } while (0)
          HG_LDV(0, 0);
#pragma unroll
          for (int hf = 0; hf < 2; ++hf) { if (hf == 0) HG_LDV(1, 4);
              SC_FENCE();
#pragma unroll
              for (int i = 0; i < 4; ++i) { const int vt = 4 * hf + i;
#pragma unroll
                  for (int k2 = 0; k2 < 2; ++k2) S[vt] = mma(xk[k2], yv[hf][2 * i + k2], S[vt]);
                  S[vt] *= eav; }
              SC_FENCE(); }
#undef HG_LDV
        }
        lds_barrier();
        f32x4 gnr[4];
#pragma unroll
        for (int q = 0; q < 4; ++q) gnr[q] = *(const LAS3 f32x4*)(gnl + 16 * (4 * hw + q) + 4 * fq);
        { const float tot = red[16 * tj + fr] + red[64 + 16 * tj + fr]; const float rstd = rsqrtf(tot * (1.0f / 128.0f) + EPS);
          bf16_t* yp = YO + (row0 + 16 * tj + fr) * 1024 + h * 128 + 4 * fq;
#pragma unroll
          for (int q = 0; q < 4; ++q) { f32x4 g;
              g[0] = __uint_as_float(hgv[q].x << 16); g[1] = __uint_as_float(hgv[q].x & 0xffff0000u); g[2] = __uint_as_float(hgv[q].y << 16); g[3] = __uint_as_float(hgv[q].y & 0xffff0000u);
              const f32x4 y = O[q] * rstd * gnr[q] * g; uint2 w; w.x = pk2(y[0], y[1]); w.y = pk2(y[2], y[3]);
              *(uint2*)(yp + 16 * (4 * hw + q)) = w; } }
    }
}
#undef HG_LOAD

DEVI void mlstm_item(LAS3 unsigned char* L, int b, int h, const bf16_t* QM, bf16_t* YO, const bf16_t* __restrict__ MU, const bf16_t* __restrict__ MV, const float* __restrict__ GATES,
                     const float* __restrict__ cw, const float* __restrict__ cb, const float* __restrict__ wq, const float* __restrict__ wk, float fb, const float* __restrict__ gnorm, unsigned* dbg) {
    (void)dbg;
    LAS3 bf16_t* UCt = (LAS3 bf16_t*)L;
    LAS3 bf16_t* WqT = UCt + 64 * PD;
    LAS3 bf16_t* WkT = WqT + 64 * PD;
    LAS3 bf16_t* Qm = WkT + 64 * PD;
    LAS3 bf16_t* Km = Qm + 64 * PS;
    LAS3 bf16_t* KwT = Km + 64 * PS;
    LAS3 bf16_t* VT = KwT + 64 * PS;
    LAS3 bf16_t* CT = VT + 144 * PS;
    LAS3 float* gvec = (LAS3 float*)(CT + 144 * PS);
    LAS3 float* Mvec = gvec + 64;
    LAS3 float* wint = Mvec + 64;
    LAS3 float* wsv = wint + 64;
    LAS3 float* emt = wsv + 64;
    LAS3 float* red = emt + 64;
    LAS3 float* scal = red + 128;
    LAS3 float* gnl = scal + 4;
    LAS3 bf16_t* Pm = UCt;
    const int tid = tid_(), wid = __builtin_amdgcn_readfirstlane(tid >> 6), lane = tid & 63, fr = lane & 15, fq = lane >> 4;
    const int ch = tid & 127, sg = tid >> 7;
    const int tj = wid & 3, hw = wid >> 2;
    for (int i = tid; i < 128 * 64; i += 512) { const int d = i >> 6, e = i & 63; WqT[e * PD + d] = f2bf(0.125f * wq[i]); WkT[e * PD + d] = f2bf(wk[i]); }
    for (int i = tid; i < 144 * PS; i += 512) { CT[i] = 0; if (i >= 128 * PS) VT[i] = (i < 129 * PS) ? (bf16_t)0x3F80 : (bf16_t)0; }
    f32x4 Cst[5];
#pragma unroll
    for (int i = 0; i < 5; ++i) Cst[i] = (f32x4){0.f, 0.f, 0.f, 0.f};
    const float cw0 = cw[ch + h * 128], cw1 = cw[512 + ch + h * 128], cw2 = cw[1024 + ch + h * 128], cw3 = cw[1536 + ch + h * 128], cbv = cb[ch + h * 128];
    float m_prev = 0.f;
    if (tid < 128) gnl[tid] = gnorm[h * 128 + tid];
    __syncthreads();
    bf16_t mur[19], vv[16]; float gin = 0.f, gfn = 0.f;
#define ML_LOAD(cc) do { const size_t r0_ = (size_t)b * SEQL + (size_t)(cc) * 64; \
        const bf16_t* mp = MU + (r0_ + 16 * sg) * 512 + h * 128 + ch; const bf16_t* vp = MV + (r0_ + 16 * sg) * 512 + h * 128 + ch; \
        _Pragma("unroll") for (int i = 0; i < 19; ++i) { const int tl = 64 * (cc) + 16 * sg + i - 3; mur[i] = (tl >= 0) ? mp[((long)i - 3) * 512] : (bf16_t)0; } \
        _Pragma("unroll") for (int i = 0; i < 16; ++i) vv[i] = vp[(size_t)i * 512]; \
        if (wid == 0) { gin = GATES[(r0_ + lane) * 8 + h]; gfn = GATES[(r0_ + lane) * 8 + 4 + h]; } } while (0)
    ML_LOAD(0);
    for (int c = 0; c < SEQL / 64; ++c) {
        const size_t row0 = (size_t)b * SEQL + (size_t)c * 64;
        { float mu[19];
#pragma unroll
          for (int i = 0; i < 19; ++i) mu[i] = bf2f(mur[i]);
#pragma unroll
          for (int i = 0; i < 16; ++i) { const float y = cbv + cw0 * mu[i] + cw1 * mu[i + 1] + cw2 * mu[i + 2] + cw3 * mu[i + 3]; UCt[(16 * sg + i) * PD + ch] = f2bf(y * __builtin_amdgcn_rcpf(1.0f + __expf(-y))); }
          unsigned vw[8];
#pragma unroll
          for (int i = 0; i < 8; ++i) vw[i] = (unsigned)vv[2 * i] | ((unsigned)vv[2 * i + 1] << 16);
          *(LAS3 u32x4v*)(VT + ch * PS + 16 * sg) = (u32x4v){vw[0], vw[1], vw[2], vw[3]}; *(LAS3 u32x4v*)(VT + ch * PS + 16 * sg + 8) = (u32x4v){vw[4], vw[5], vw[6], vw[7]}; }
        uint2 mov[4];
#pragma unroll
        for (int q = 0; q < 4; ++q) mov[q] = *(const uint2*)(QM + (row0 + 16 * tj + fr) * 1024 + 512 + h * 128 + 16 * (4 * hw + q) + 4 * fq);
        const float gmi = gin, gmf = gfn;
        if (c + 1 < SEQL / 64) ML_LOAD(c + 1);
        if (wid == 0) {
            const float mi = gmi, z = gmf + fb;
            const float lf = fminf(z, 0.f) - log1pf(__expf(-fabsf(z)));
            const float bsum = wave_scan_sum(lf);
            const float g = mi - bsum; const float cm = wave_scan_max(g);
            const float M = fmaxf(m_prev, cm);
            const float M63 = lane63(M), b63 = lane63(bsum);
            gvec[lane] = g; Mvec[lane] = M; wint[lane] = __expf(m_prev - M); wsv[lane] = __expf(g - M63); emt[lane] = __expf(-(bsum + M));
            if (lane == 0) scal[0] = __expf(m_prev - M63);
            m_prev = b63 + M63;
        }
        lds_barrier();
        { bf16x8 yu[4], xw[2][8];
#pragma unroll
          for (int k4 = 0; k4 < 4; ++k4) yu[k4] = ldf(UCt, PD, 16 * tj + fr, 32 * k4 + 8 * fq);
#define ML_LDW(buf, q2_) do { const int ei_ = 2 * hw + (q2_); _Pragma("unroll") for (int k4 = 0; k4 < 4; ++k4) { xw[buf][k4] = ldf(WqT, PD, 16 * ei_ + fr, 32 * k4 + 8 * fq); xw[buf][4 + k4] = ldf(WkT, PD, 16 * ei_ + fr, 32 * k4 + 8 * fq); } } while (0)
          ML_LDW(0, 0);
#pragma unroll
          for (int q2 = 0; q2 < 2; ++q2) { const int ei = 2 * hw + q2; f32x4 aq = (f32x4){0.f, 0.f, 0.f, 0.f}, ak = aq, akt = aq;
              if (q2 == 0) ML_LDW(1, 1);
              SC_FENCE();
#pragma unroll
              for (int k4 = 0; k4 < 4; ++k4) { aq = mma(xw[q2][k4], yu[k4], aq); ak = mma(xw[q2][4 + k4], yu[k4], ak); akt = mma(yu[k4], xw[q2][4 + k4], akt); }
              SC_FENCE();
              st4(Qm + (16 * tj + fr) * PS + 16 * ei + 4 * fq, aq); st4(Km + (16 * tj + fr) * PS + 16 * ei + 4 * fq, ak);
              const f32x4 wv = *(const LAS3 f32x4*)(wsv + 16 * tj + 4 * fq);
              st4(KwT + (16 * ei + fr) * PS + 16 * tj + 4 * fq, akt * wv); }
#undef ML_LDW
        }
        lds_barrier();
        { const int ti = wid >> 1; const float Mt = Mvec[16 * ti + fr]; bf16x8 yq2[2], xk2[2][2];
#pragma unroll
          for (int k2 = 0; k2 < 2; ++k2) yq2[k2] = ldf(Qm, PS, 16 * ti + fr, 32 * k2 + 8 * fq);
#pragma unroll
          for (int q2 = 0; q2 < 2; ++q2)
#pragma unroll
              for (int k2 = 0; k2 < 2; ++k2) xk2[q2][k2] = ldf(Km, PS, 16 * (2 * (wid & 1) + q2) + fr, 32 * k2 + 8 * fq);
          SC_FENCE();
#pragma unroll
          for (int q2 = 0; q2 < 2; ++q2) { const int si = 2 * (wid & 1) + q2; f32x4 acc = (f32x4){0.f, 0.f, 0.f, 0.f};
#pragma unroll
              for (int k2 = 0; k2 < 2; ++k2) acc = mma(xk2[q2][k2], yq2[k2], acc);
              const int t = 16 * ti + fr, s0 = 16 * si + 4 * fq; const f32x4 gv = *(const LAS3 f32x4*)(gvec + s0);
#pragma unroll
              for (int j = 0; j < 4; ++j) acc[j] = (s0 + j <= t) ? acc[j] * __expf(gv[j] - Mt) : 0.f;
              st4(Pm + t * PS + s0, acc); } }
        lds_barrier();
        f32x4 O[4]; float den;
        { bf16x8 yq[2], yp[2], xk[2], vt[5][2], ct[2][2];
#pragma unroll
          for (int k2 = 0; k2 < 2; ++k2) { yq[k2] = ldf(Qm, PS, 16 * tj + fr, 32 * k2 + 8 * fq); yp[k2] = ldf(Pm, PS, 16 * tj + fr, 32 * k2 + 8 * fq); }
#define ML_VI(q_) (((q_) < 4) ? 4 * hw + (q_) : 8)
#pragma unroll
          for (int k2 = 0; k2 < 2; ++k2) ct[0][k2] = ldf(CT, PS, 16 * ML_VI(0) + fr, 32 * k2 + 8 * fq);
#pragma unroll
          for (int q = 0; q < 5; ++q)
#pragma unroll
              for (int k2 = 0; k2 < 2; ++k2) vt[q][k2] = ldf(VT, PS, 16 * ML_VI(q) + fr, 32 * k2 + 8 * fq);
#pragma unroll
          for (int k2 = 0; k2 < 2; ++k2) xk[k2] = ldf(KwT, PS, 16 * tj + fr, 32 * k2 + 8 * fq);
          const float wi = wint[16 * tj + fr];
          const float dp = scal[0];
#pragma unroll
          for (int q = 0; q < 5; ++q) { f32x4 acc = (f32x4){0.f, 0.f, 0.f, 0.f};
              if (q < 4) {
#pragma unroll
                  for (int k2 = 0; k2 < 2; ++k2) ct[(q + 1) & 1][k2] = ldf(CT, PS, 16 * ML_VI(q + 1) + fr, 32 * k2 + 8 * fq); }
              SC_FENCE();
#pragma unroll
              for (int k2 = 0; k2 < 2; ++k2) acc = mma(ct[q & 1][k2], yq[k2], acc);
              acc *= wi;
#pragma unroll
              for (int k2 = 0; k2 < 2; ++k2) acc = mma(vt[q][k2], yp[k2], acc);
              SC_FENCE();
              if (q < 4) O[q] = acc; else den = __shfl(acc[0], fr); }
          const float dn = __builtin_amdgcn_rcpf(fmaxf(fabsf(den), emt[16 * tj + fr])); float ss = 0.f;
#pragma unroll
          for (int q = 0; q < 4; ++q) { O[q] *= dn; ss += O[q][0] * O[q][0] + O[q][1] * O[q][1] + O[q][2] * O[q][2] + O[q][3] * O[q][3]; }
          ss += __shfl_xor(ss, 16); ss += __shfl_xor(ss, 32);
          if (fq == 0) red[hw * 64 + 16 * tj + fr] = ss;
#pragma unroll
          for (int q = 0; q < 5; ++q) { if (q == 4 && hw != 0) break; Cst[q] *= dp;
#pragma unroll
              for (int k2 = 0; k2 < 2; ++k2) Cst[q] = mma(xk[k2], vt[q][k2], Cst[q]); }
#undef ML_VI
        }
        lds_barrier();
        f32x4 gnr[4];
#pragma unroll
        for (int q = 0; q < 4; ++q) gnr[q] = *(const LAS3 f32x4*)(gnl + 16 * (4 * hw + q) + 4 * fq);
        { const float tot = red[16 * tj + fr] + red[64 + 16 * tj + fr]; const float rstd = rsqrtf(tot * (1.0f / 128.0f) + EPS);
          bf16_t* yp = YO + (row0 + 16 * tj + fr) * 1024 + 512 + h * 128 + 4 * fq;
#pragma unroll
          for (int q = 0; q < 4; ++q) { f32x4 g;
              g[0] = __uint_as_float(mov[q].x << 16); g[1] = __uint_as_float(mov[q].x & 0xffff0000u); g[2] = __uint_as_float(mov[q].y << 16); g[3] = __uint_as_float(mov[q].y & 0xffff0000u);
              const f32x4 y = O[q] * rstd * gnr[q] * g; uint2 w; w.x = pk2(y[0], y[1]); w.y = pk2(y[2], y[3]);
              *(uint2*)(yp + 16 * (4 * hw + q)) = w; }
#pragma unroll
          for (int q = 0; q < 5; ++q) { if (q == 4 && hw != 0) break; const int vi = (q < 4) ? 4 * hw + q : 8; st4(CT + (16 * vi + fr) * PS + 16 * tj + 4 * fq, Cst[q]); } }
    }
}
#undef ML_LOAD
struct ScanArgs { const bf16_t* QM; bf16_t* YO; const float* LF; const bf16_t* HI; const bf16_t* HG; const bf16_t* MU; const bf16_t* MV; const float* GATES;
                  const float* hg_norm_g; const float* ml_norm_g; const float* conv_w; const float* conv_b; const float* wq; const float* wk; const float* fbias; unsigned* dbg; };
DEVI void scan_item(LAS3 unsigned char* L, const ScanArgs& a, int item) {
    const int bh = item & 127, b = bh >> 2, h = bh & 3;
    if (item < 128) hgrn2_item(L, b, h, a.QM, a.YO, a.LF, a.HI, a.HG, a.hg_norm_g);
    else mlstm_item(L, b, h, a.QM, a.YO, a.MU, a.MV, a.GATES, a.conv_w, a.conv_b, a.wq + (size_t)h * 128 * 64, a.wk + (size_t)h * 128 * 64, a.fbias[h], a.ml_norm_g, a.dbg);
}
}
constexpr size_t WT_IN = 0;
constexpr size_t WT_BRH = WT_IN + 2ull * 5632 * 1024;
constexpr size_t WT_BRM = WT_BRH + 2ull * 1024 * 512;
constexpr size_t WT_OUT = WT_BRM + 2ull * 1024 * 512;
constexpr size_t WT_F13 = WT_OUT + 2ull * 1024 * 1024;
constexpr size_t WT_F2 = WT_F13 + 5632ull * 1024;
constexpr size_t WT_M13 = WT_F2 + 1024ull * 2816;
constexpr size_t WT_M2 = WT_M13 + 8ull * 2816 * 1024;
constexpr size_t WT_END = WT_M2 + 8ull * 1024 * 1408;
static_assert(WT_END * 2 <= 120 * MiB, "weights region");


#define XB_TMO      128
#define XB_XCNT(j)  (256  + 64 * (j))
#define XB_XSUB(j)  (1280 + 64 * (j))
#define XB_XGEN(j)  (2304 + 64 * (j))
#define XB_TOP      3328
#define XB_TOPGEN   3392
#define XCD_BAR_WORDS 3456
#define XB_SPIN_CAP (1u << 18)
#define LAS __attribute__((address_space(3)))
__device__ __forceinline__ unsigned xb_ld(unsigned* p)              { return __hip_atomic_load(p, __ATOMIC_RELAXED, __HIP_MEMORY_SCOPE_AGENT); }
__device__ __forceinline__ unsigned xb_add(unsigned* p, unsigned v) { return __hip_atomic_fetch_add(p, v, __ATOMIC_RELAXED, __HIP_MEMORY_SCOPE_AGENT); }
__device__ __forceinline__ unsigned xb_xcc_id() { return (unsigned)__builtin_amdgcn_s_getreg((3 << 11) | 20) & 0xFu; }
#define XB_SPIN(cond, bar) do { unsigned _sp = 0; while (cond) { __builtin_amdgcn_s_sleep(1); \
    if ((++_sp & 255u) == 0u) { if (xb_ld(&(bar)[XB_TMO])) break; if (_sp > XB_SPIN_CAP) { atomicAdd(&(bar)[XB_TMO], 1u); break; } } } } while (0)
struct XcdBarrier { unsigned* bar; unsigned x; volatile LAS unsigned* st; };
__device__ __forceinline__ XcdBarrier xcd_barrier_post(unsigned* bar, volatile LAS unsigned* st) {
    XcdBarrier b; b.bar = bar; b.x = xb_xcc_id(); b.st = st;
    if (tid_() == 0) (void)xb_add(&bar[XB_XCNT(b.x)], 1u);
    return b;
}
__device__ __forceinline__ void xcd_barrier_complete(unsigned* bar, unsigned x, unsigned& nloc, unsigned& nx) {
    const unsigned G = gridDim.x * gridDim.y * gridDim.z;
    unsigned sum, cnt, mine, sp = 0u;
    for (;;) {
        sum = 0u; cnt = 0u; mine = 0u;
#pragma unroll
        for (unsigned j = 0; j < 16; ++j) { const unsigned c = xb_ld(&bar[XB_XCNT(j)]); sum += c; cnt += (c > 0u) ? 1u : 0u; mine = (j == x) ? c : mine; }
        if (sum == G) break;
        __builtin_amdgcn_s_sleep(1);
        if ((++sp & 255u) == 0u) { if (xb_ld(&bar[XB_TMO])) break; if (sp > XB_SPIN_CAP) { atomicAdd(&bar[XB_TMO], 1u); break; } }
    }
    nloc = mine > 0u ? mine : 1u; nx = cnt > 0u ? cnt : 1u;
}
__device__ __forceinline__ void xcd_barrier(const XcdBarrier& b) {
    asm volatile("s_waitcnt vmcnt(0)" ::: "memory");
    __syncthreads();
    if (tid_() == 0) {
        unsigned* bar = b.bar;
        __builtin_amdgcn_s_waitcnt(0);
        unsigned nloc = b.st[0], nx = b.st[1];
        if (nloc == 0u) { xcd_barrier_complete(bar, b.x, nloc, nx); b.st[0] = nloc; b.st[1] = nx; }
        const unsigned old = xb_add(&bar[XB_XSUB(b.x)], 1u);
        const unsigned gen = old / nloc;
        if (old + 1u == (gen + 1u) * nloc) {
            __builtin_amdgcn_fence(__ATOMIC_RELEASE, "agent");
            asm volatile("s_waitcnt vmcnt(0)" ::: "memory");
            const unsigned og = xb_add(&bar[XB_TOP], 1u);
            const unsigned tg = og / nx;
            if (og + 1u == (tg + 1u) * nx) xb_add(&bar[XB_TOPGEN], 1u);
            else XB_SPIN(xb_ld(&bar[XB_TOPGEN]) == tg, bar);
            __builtin_amdgcn_fence(__ATOMIC_ACQUIRE, "agent");
            xb_add(&bar[XB_XGEN(b.x)], 1u);
            asm volatile("s_waitcnt vmcnt(0)" ::: "memory");
        } else {
            XB_SPIN(xb_ld(&bar[XB_XGEN(b.x)]) == gen, bar);
            __builtin_amdgcn_fence(__ATOMIC_ACQUIRE, "agent");
            asm volatile("s_waitcnt vmcnt(0)" ::: "memory");
        }
    }
    __syncthreads();
}

enum { I_X = 0, I_C, I_NORM_MIX_G, I_ADA_MIX_W, I_ADA_MIX_B, I_W_IN, I_LB, I_HG_NORM, I_CONV_W, I_CONV_B, I_WQ, I_WK, I_FBIAS, I_ML_NORM, I_BRH, I_BRM, I_WOUT,
       I_NORM_FFN_G, I_ADA_FFN_W, I_ADA_FFN_B, I_FW1, I_FW3, I_FW2, I_RW, I_RB, I_MW1, I_MW3, I_MW2, I_FINAL_G, N_IN };
struct Params { const float* in[N_IN]; float* out; unsigned char* ws; CvtJobs J; };
constexpr size_t OFF_BAR = OFF_MISC + 16 * 1024;
constexpr size_t OFF_CTR = OFF_MISC + 12 * 1024;
constexpr size_t OFF_MOECNT = OFF_CTR + 1024;
constexpr size_t OFF_LBT = OFF_MISC + 4096;
constexpr int LDS_BYTES = 128 * 1024 + 1024;
constexpr int LDSCTL = 128 * 1024;

DEVI void ada_unit(const Params& p, int unit, LAS3 unsigned char* lds, float* __restrict__ mod) {
    const int tid = tid_(), lane = tid & 63, kg = tid >> 6;
    const int s = unit / 48, jc = unit % 48, l = s >> 1, sub = s & 1;
    const float* W = (sub ? p.in[I_ADA_FFN_W] : p.in[I_ADA_MIX_W]) + (size_t)l * 1024 * 3072;
    const float* Bv = (sub ? p.in[I_ADA_FFN_B] : p.in[I_ADA_MIX_B]) + (size_t)l * 3072;
    const float* c = p.in[I_C];
    const int j = jc * 64 + lane;
    LAS3 float* ca = (LAS3 float*)lds;
    float acc[32];
#pragma unroll
    for (int b = 0; b < 32; ++b) acc[b] = 0.f;
    for (int k0 = 0; k0 < 1024; k0 += 256) {
#pragma unroll
        for (int i = 0; i < 16; ++i) { const int idx = tid + i * 512, bb = idx & 31, kk = idx >> 5; ca[kk * 32 + bb] = siluf_(c[bb * 1024 + k0 + kk]); }
        __syncthreads();
        for (int kk = 0; kk < 32; ++kk) { const int kl = kg * 32 + kk; const float wv = W[(size_t)(k0 + kl) * 3072 + j];
#pragma unroll
            for (int b4 = 0; b4 < 8; ++b4) { const sc::f32x4 cv = *(const LAS3 sc::f32x4*)(ca + kl * 32 + 4 * b4);
                acc[4 * b4] += cv[0] * wv; acc[4 * b4 + 1] += cv[1] * wv; acc[4 * b4 + 2] += cv[2] * wv; acc[4 * b4 + 3] += cv[3] * wv; } }
        __syncthreads();
    }
    LAS3 float* red = (LAS3 float*)lds;
#pragma unroll
    for (int b = 0; b < 32; ++b) red[(kg * 32 + b) * 64 + lane] = acc[b];
    __syncthreads();
#pragma unroll
    for (int i = 0; i < 4; ++i) { const int o = tid + i * 512, b = o >> 6, cl = o & 63; float sum = 0.f;
#pragma unroll
        for (int g = 0; g < 8; ++g) sum += red[(g * 32 + b) * 64 + cl];
        mod[((size_t)s * 32 + b) * 3072 + jc * 64 + cl] = sum + Bv[jc * 64 + cl]; }
    __syncthreads();
}
constexpr int CVT_LDS = 96 * 1024;
DEVI CvtJob cvt_lookup(const LAS3 unsigned* tb, int gt) {
    int ji = 0;
#pragma unroll
    for (int q = 1; q < N_CVT; ++q) ji = (gt >= (int)tb[q * (int)(sizeof(CvtJob) / 4) + (int)(offsetof(CvtJob, tile0) / 4)]) ? q : ji;
    const LAS3 unsigned* r = tb + ji * (int)(sizeof(CvtJob) / 4);
    CvtJob jb;
    jb.src = (const float*)(((unsigned long long)r[1] << 32) | r[0]); jb.dst = (bf16_t*)(((unsigned long long)r[3] << 32) | r[2]); jb.src_bstride = (long long)(((unsigned long long)r[5] << 32) | r[4]);
    jb.K = (int)r[6]; jb.ncols = (int)r[7]; jb.ldsrc = (int)r[8]; jb.nb = (int)r[9]; jb.dst_rows_per_batch = (int)r[10]; jb.mode = (int)r[11]; jb.tile0 = (int)r[12]; jb.f8 = (int)r[13]; jb.dst_ld = (int)r[14]; jb.pad = ji;
    return jb;
}
DEVI void ph_prologue(const Params& p, LAS3 unsigned char* lds) {
    const int tid = tid_(), half = tid >> 8, t = tid & 255;
    unsigned char* ws = p.ws;
    for (int u = (int)blockIdx.x; u < 192; u += (int)gridDim.x) ada_unit(p, u, lds, (float*)(ws + OFF_MOD));
    if (blockIdx.x == gridDim.x - 1) { const float* lg = p.in[I_LB]; float* lb = (float*)(ws + OFF_LBT); const float z0 = lg[tid], z1 = lg[512 + tid]; lb[tid] = 0.f; lb[512 + tid] = 1.0f / (1.0f + __expf(z0 - z1)); }
    if (MOED_F8) { unsigned char* w2 = (unsigned char*)((bf16_t*)(ws + OFF_WEIGHTS) + WT_M2);
        for (int i = (int)blockIdx.x * 512 + tid; i < 8192 * 8; i += (int)gridDim.x * 512) *(uint4*)(w2 + (size_t)(i >> 3) * KD8 + D_FFE + (i & 7) * 16) = make_uint4(0u, 0u, 0u, 0u); }
    LAS3 float* tile = (LAS3 float*)(lds + half * (64 * MT_PITCH * 4));
    LAS3 unsigned* tb = (LAS3 unsigned*)(lds + CVT_LDS);
    { const unsigned* ka = (const unsigned*)__builtin_amdgcn_kernarg_segment_ptr() + offsetof(Params, J) / 4;
      for (int i = tid; i < (int)(sizeof(CvtJobs) / 4); i += 512) tb[i] = ka[i];
      __syncthreads(); }
    LAS3 float* wql = (LAS3 float*)(lds + CVT_LDS + 2048);
    if (USE_I8) {
        LAS3 float* wpart = wql + N_CVT;
        float ssj[N_I8J];
#pragma unroll
        for (int i = 0; i < N_I8J; ++i) { const LAS3 unsigned* r = tb + i8job(i) * (int)(sizeof(CvtJob) / 4);
            const float* sp = (const float*)(((unsigned long long)r[1] << 32) | r[0]); const int ldsrc = (int)r[8]; float a = 0.f;
#pragma unroll
            for (int q = 0; q < 4; ++q) { const vf4 x = *(const vf4*)(sp + (size_t)((tid >> 5) + 16 * q) * ldsrc + (tid & 31) * 4); a += x[0] * x[0] + x[1] * x[1] + x[2] * x[2] + x[3] * x[3]; }
            ssj[i] = a; }
#pragma unroll
        for (int i = 0; i < N_I8J; ++i) { const float a = wave_sum(ssj[i]); if ((tid & 63) == 0) wpart[i * 8 + (tid >> 6)] = a; }
        __syncthreads();
        if (tid < N_I8J) { float tot = 0.f;
#pragma unroll
            for (int w = 0; w < 8; ++w) tot += wpart[tid * 8 + w];
            const float clip = fmaxf(I8_CLIP * sqrtf(tot * (1.0f / 8192.0f)), 1e-30f);
            wql[i8job(tid)] = 127.0f / clip;
            if (blockIdx.x == 0) ((float*)(ws + OFF_WSTEP))[i8job(tid)] = clip * (1.0f / 127.0f); }
        __syncthreads();
    }
    const int total = (int)tb[N_CVT * (int)(sizeof(CvtJob) / 4)], nh = 2 * (int)gridDim.x, hid = 2 * (int)blockIdx.x + half;
    vf4 ldA[8], ldB[8];
    int mtA = hid, mtB = hid + nh; bool actA = mtA < total, actB = mtB < total; CvtJob jbA = cvt_lookup(tb, mtA), jbB = cvt_lookup(tb, mtB);
    if (actA) cvt_mt_load(jbA, mtA - jbA.tile0, t, ldA);
    if (actB) cvt_mt_load(jbB, mtB - jbB.tile0, t, ldB);
    for (int base = 0; base < total; base += 2 * nh) {
        if (actA) cvt_mt_lds(t, ldA, tile);
        __syncthreads();
        { const int mtn = mtA + 2 * nh; const bool actn = mtn < total; const CvtJob jbn = cvt_lookup(tb, mtn);
          if (actA) cvt_mt_store(jbA, mtA - jbA.tile0, t, tile, wql);
          if (actn) cvt_mt_load(jbn, mtn - jbn.tile0, t, ldA);
          mtA = mtn; actA = actn; jbA = jbn; }
        __syncthreads();
        if (actB) cvt_mt_lds(t, ldB, tile);
        __syncthreads();
        { const int mtn = mtB + 2 * nh; const bool actn = mtn < total; const CvtJob jbn = cvt_lookup(tb, mtn);
          if (actB) cvt_mt_store(jbB, mtB - jbB.tile0, t, tile, wql);
          if (actn) cvt_mt_load(jbn, mtn - jbn.tile0, t, ldB);
          mtB = mtn; actB = actn; jbB = jbn; }
        __syncthreads();
    }
}

constexpr int NORM_LCNT = 8 * 1024 * 4;
constexpr int NORM_VEC = 40 * 1024;
template <int MODE, int FMT, bool XF32>
DEVI void ph_norm(LAS3 unsigned char* lds, const void* __restrict__ x, const float* __restrict__ g, const float* __restrict__ mod, bf16_t* __restrict__ H, const float* __restrict__ wext, const float* __restrict__ rbias,
                  float* __restrict__ gates_out, int* __restrict__ ridx, float* __restrict__ rgate, int* __restrict__ rrank, int* __restrict__ cnt, int* __restrict__ wgbase, float* __restrict__ rs_out = nullptr) {
    constexpr bool F8 = (FMT == 1);
    const int lane = tid_() & 63, wave = __builtin_amdgcn_readfirstlane(tid_() >> 6);
    constexpr int LD = (MODE == 0) ? IN_COLS : 8;
    LAS3 int* lcnt = (LAS3 int*)(lds + NORM_LCNT);
    sc::f32x4 wr[16][2];
    if (MODE != 1) {
#pragma unroll
        for (int i = 0; i < 4; ++i)
#pragma unroll
            for (int j = 0; j < 4; ++j) { const int col = XF32 ? (lane + 64 * i) * 4 + j : (lane + 64 * (i >> 1)) * 8 + 4 * (i & 1) + j; const sc::f32x4* wp = (const sc::f32x4*)(wext + (size_t)col * LD); wr[4 * i + j][0] = wp[0]; wr[4 * i + j][1] = wp[1]; }
        if (MODE == 2 && tid_() < 8) lcnt[tid_()] = 0;
        __syncthreads();
    }
    LAS3 float* gmv = (LAS3 float*)(lds + NORM_VEC); LAS3 float* shv = gmv + 1024;
    for (int pm = (int)blockIdx.x; pm < TOK / 256; pm += (int)gridDim.x) {
      { const int b = pm >> 3; const float* mb = mod + (size_t)b * 3072;
        for (int k = tid_(); k < 1024; k += 512) { gmv[k] = g[k] * (1.f + mb[1024 + k]); shv[k] = mb[k]; }
        __syncthreads(); }
      int cols[4];
#pragma unroll
      for (int i = 0; i < 4; ++i) cols[i] = XF32 ? (lane + 64 * i) * 4 : (lane + 64 * (i >> 1)) * 8 + 4 * (i & 1);
      float4 nf[4]; uint4 nw[2];
      { const int row = pm * 256 + wave;
        if (XF32) { const float4* xr = (const float4*)((const float*)x + (size_t)row * 1024);
#pragma unroll
            for (int i = 0; i < 4; ++i) nf[i] = xr[lane + 64 * i]; }
        else { const uint4* xr = (const uint4*)((const bf16_t*)x + (size_t)row * 1024);
#pragma unroll
            for (int i = 0; i < 2; ++i) nw[i] = xr[lane + 64 * i]; } }
      for (int rr = wave; rr < 256; rr += 8) {
        const int row = pm * 256 + rr;
        float4 v[4]; float ss = 0.f;
        if (XF32) {
#pragma unroll
            for (int i = 0; i < 4; ++i) v[i] = nf[i]; }
        else {
#pragma unroll
            for (int i = 0; i < 2; ++i) { const uint4 w = nw[i];
                v[2 * i] = make_float4(__uint_as_float(w.x << 16), __uint_as_float(w.x & 0xffff0000u), __uint_as_float(w.y << 16), __uint_as_float(w.y & 0xffff0000u));
                v[2 * i + 1] = make_float4(__uint_as_float(w.z << 16), __uint_as_float(w.z & 0xffff0000u), __uint_as_float(w.w << 16), __uint_as_float(w.w & 0xffff0000u)); } }
        if (rr + 8 < 256) {
            if (XF32) { const float4* xr = (const float4*)((const float*)x + (size_t)(row + 8) * 1024);
#pragma unroll
                for (int i = 0; i < 4; ++i) nf[i] = xr[lane + 64 * i]; }
            else { const uint4* xr = (const uint4*)((const bf16_t*)x + (size_t)(row + 8) * 1024);
#pragma unroll
                for (int i = 0; i < 2; ++i) nw[i] = xr[lane + 64 * i]; } }
#pragma unroll
        for (int i = 0; i < 4; ++i) ss += v[i].x * v[i].x + v[i].y * v[i].y + v[i].z * v[i].z + v[i].w * v[i].w;
        ss = wave_sum(ss);
        const float rstd = rsqrtf(ss * (1.0f / 1024.0f) + EPS);
        typedef float f32x2_t __attribute__((ext_vector_type(2)));
        f32x2_t ext2[4];
#pragma unroll
        for (int e = 0; e < 4; ++e) ext2[e] = (f32x2_t){0.f, 0.f};
        float hq[4][4]; float amax = 0.f;
#pragma unroll
        for (int i = 0; i < 4; ++i) {
            const int col = cols[i];
            const sc::f32x4 gm = *(const LAS3 sc::f32x4*)(gmv + col), sh = *(const LAS3 sc::f32x4*)(shv + col);
            float hv[4];
            hv[0] = v[i].x * rstd * gm[0] + sh[0]; hv[1] = v[i].y * rstd * gm[1] + sh[1];
            hv[2] = v[i].z * rstd * gm[2] + sh[2]; hv[3] = v[i].w * rstd * gm[3] + sh[3];
            if (FMT == 2) {
#pragma unroll
                for (int j = 0; j < 4; ++j) { hq[i][j] = hv[j]; amax = fmaxf(amax, fabsf(hv[j])); } }
            else if (F8) { unsigned q8 = 0u; q8 = __builtin_amdgcn_cvt_pk_fp8_f32(sat8(hv[0]), sat8(hv[1]), q8, false); q8 = __builtin_amdgcn_cvt_pk_fp8_f32(sat8(hv[2]), sat8(hv[3]), q8, true);
                *(unsigned*)((unsigned char*)H + (size_t)row * 1024 + col) = q8; }
            else { uint2 pk; pk.x = cvt2bf(hv[0], hv[1]); pk.y = cvt2bf(hv[2], hv[3]);
            *(uint2*)(H + (size_t)row * 1024 + col) = pk; }
            if (MODE != 1) {
#pragma unroll
                for (int j = 0; j < 4; ++j) { const f32x2_t hh = (f32x2_t){hv[j], hv[j]};
#pragma unroll
                    for (int q = 0; q < 2; ++q) { const sc::f32x4 w = wr[4 * i + j][q];
                        ext2[2 * q] = __builtin_elementwise_fma(hh, (f32x2_t){w[0], w[1]}, ext2[2 * q]); ext2[2 * q + 1] = __builtin_elementwise_fma(hh, (f32x2_t){w[2], w[3]}, ext2[2 * q + 1]); } }
            }
        }
        if (FMT == 2) {
            amax = fmaxf(wave_max(amax), 1e-30f);
            const float inv = 127.0f / amax;
#pragma unroll
            for (int i = 0; i < 4; ++i) *(unsigned*)((unsigned char*)H + (size_t)row * 1024 + cols[i]) = pack_i8x4(hq[i][0] * inv, hq[i][1] * inv, hq[i][2] * inv, hq[i][3] * inv);
            if (lane == 0) rs_out[row] = amax * (1.0f / 127.0f);
        }
        if (MODE != 1) {
            float ext[8];
            { float xs[8];
#pragma unroll
              for (int e = 0; e < 8; ++e) xs[e] = ext2[e >> 1][e & 1];
              const float tot = wave_sum8(xs, lane);
#pragma unroll
              for (int e = 0; e < 8; ++e) ext[e] = __int_as_float(__builtin_amdgcn_readlane(__float_as_int(tot), e)); }
            if (MODE == 0) { if (lane == 0) { *(float4*)(gates_out + (size_t)row * 8) = make_float4(ext[0], ext[1], ext[2], ext[3]); *(float4*)(gates_out + (size_t)row * 8 + 4) = make_float4(ext[4], ext[5], ext[6], ext[7]); } }
            else {
                float best = -3.0e38f, second = -3.0e38f; int bi = 0, si = 0;
#pragma unroll
                for (int e = 0; e < 8; ++e) { const float lv = ext[e] + rbias[e];
                    if (lv > best) { second = best; si = bi; best = lv; bi = e; } else if (lv > second) { second = lv; si = e; } }
                if (lane == 0) {
                    const float e1 = __expf(second - best), g0 = 1.0f / (1.0f + e1), g1 = e1 / (1.0f + e1);
                    ridx[row * 2] = bi; ridx[row * 2 + 1] = si; rgate[row * 2] = g0; rgate[row * 2 + 1] = g1;
                    rrank[row * 2] = atomicAdd((int*)(lcnt + bi), 1); rrank[row * 2 + 1] = atomicAdd((int*)(lcnt + si), 1);
                }
            }
        }
      }
      __syncthreads();
    }
    if (MODE == 2) {
        __syncthreads();
        if (tid_() < 8) wgbase[(int)blockIdx.x * 8 + tid_()] = atomicAdd(&cnt[tid_()], lcnt[tid_()]);
    }
}

struct MoeBases { int b[9]; };
DEVI MoeBases moe_bases(const int* __restrict__ cnt) {
    MoeBases m; int acc = 0;
#pragma unroll
    for (int e = 0; e < 8; ++e) { m.b[e] = acc; acc += (__builtin_amdgcn_readfirstlane(cnt[e]) + 255) & ~255; }
    m.b[8] = acc; return m;
}
namespace pg8 {
struct MoeOrder2 {
    MoeBases mb; int nN, G, c;
    __device__ bool next(int i, Unit& u) const {
        const int nt = mb.b[8] >> 8; const long L = (long)i * G + c; if (L >= (long)nt * nN) return false;
        const int pm = (int)(L / nN), pnl = (int)(L % nN), row = pm * 256; int e = 0;
#pragma unroll
        for (int q = 1; q < 8; ++q) e += (row >= mb.b[q]) ? 1 : 0;
        u.pm = pm; u.pn = e * nN + pnl; u.acol = 0; return true;
    }
};
}
DEVI void ph_gather(const bf16_t* __restrict__ H, const int* __restrict__ ridx, const int* __restrict__ rrank, const int* __restrict__ wgbase, const MoeBases& mb, int* __restrict__ rpos, bf16_t* __restrict__ A2, const float* __restrict__ rsH, float* __restrict__ rsE) {
    const int lane = tid_() & 63, wave = __builtin_amdgcn_readfirstlane(tid_() >> 6);
    constexpr bool B1 = (MOE_F8 || USE_I8);
    for (int t0 = 4 * ((int)blockIdx.x * 8 + wave); t0 < TOK; t0 += 4 * (int)gridDim.x * 8) {
        uint4 r0[4], r1[4];
#pragma unroll
        for (int i = 0; i < 4; ++i) {
            if (B1) r0[i] = ((const uint4*)((const unsigned char*)H + (size_t)(t0 + i) * 1024))[lane];
            else { const uint4* src = (const uint4*)(H + (size_t)(t0 + i) * 1024); r0[i] = src[lane]; r1[i] = src[lane + 64]; } }
        int pz = 0;
        if (lane < 8) { const int w = 2 * t0 + lane, t = w >> 1; const int e = ridx[w]; int base = 0;
#pragma unroll
            for (int q = 1; q < 8; ++q) base = (e == q) ? mb.b[q] : base;
            pz = base + wgbase[((t >> 8) % (int)gridDim.x) * 8 + e] + rrank[w];
            rpos[w] = pz; if (USE_I8) rsE[pz] = rsH[t]; }
#pragma unroll
        for (int j = 0; j < 8; ++j) { const int pj = __builtin_amdgcn_readlane(pz, j);
            if (B1) ((uint4*)((unsigned char*)A2 + (size_t)pj * 1024))[lane] = r0[j >> 1];
            else { uint4* dst = (uint4*)(A2 + (size_t)pj * 1024); dst[lane] = r0[j >> 1]; dst[lane + 64] = r1[j >> 1]; } }
    }
}
DEVI void ph_final(LAS3 unsigned char* lds, const bf16_t* __restrict__ x, const float* __restrict__ mod, const bf16_t* __restrict__ YE, const int* __restrict__ rpos, const float* __restrict__ rgate, const float* __restrict__ fg, float* out) {
    const int lane = tid_() & 63, wave = __builtin_amdgcn_readfirstlane(tid_() >> 6);
    LAS3 float* gtv = (LAS3 float*)lds; LAS3 float* fgv = gtv + 1024;
    for (int pm = (int)blockIdx.x; pm < TOK / 256; pm += (int)gridDim.x) {
      { const float* mb = mod + (size_t)(pm >> 3) * 3072 + 2048;
        for (int k = tid_(); k < 1024; k += 512) { gtv[k] = mb[k]; fgv[k] = fg[k]; }
        __syncthreads(); }
      for (int rr = wave; rr < 256; rr += 8) {
        const int row = pm * 256 + rr;
        const int p0 = rpos[row * 2], p1 = rpos[row * 2 + 1]; const float g0 = rgate[row * 2], g1 = rgate[row * 2 + 1];
        float4 v[4]; float ss = 0.f;
#pragma unroll
        for (int i = 0; i < 4; ++i) {
            const int col = (lane + 64 * i) * 4;
            const uint2 xw = *(const uint2*)(x + (size_t)row * 1024 + col);
            const float4 xv = make_float4(__uint_as_float(xw.x << 16), __uint_as_float(xw.x & 0xffff0000u), __uint_as_float(xw.y << 16), __uint_as_float(xw.y & 0xffff0000u));
            const sc::f32x4 gt = *(const LAS3 sc::f32x4*)(gtv + col);
            const uint2 y0 = *(const uint2*)(YE + (size_t)p0 * 1024 + col), y1 = *(const uint2*)(YE + (size_t)p1 * 1024 + col);
            v[i].x = xv.x + gt[0] * (g0 * __uint_as_float(y0.x << 16) + g1 * __uint_as_float(y1.x << 16));
            v[i].y = xv.y + gt[1] * (g0 * __uint_as_float(y0.x & 0xffff0000u) + g1 * __uint_as_float(y1.x & 0xffff0000u));
            v[i].z = xv.z + gt[2] * (g0 * __uint_as_float(y0.y << 16) + g1 * __uint_as_float(y1.y << 16));
            v[i].w = xv.w + gt[3] * (g0 * __uint_as_float(y0.y & 0xffff0000u) + g1 * __uint_as_float(y1.y & 0xffff0000u));
            ss += v[i].x * v[i].x + v[i].y * v[i].y + v[i].z * v[i].z + v[i].w * v[i].w;
        }
        ss = wave_sum(ss);
        const float rstd = rsqrtf(ss * (1.0f / 1024.0f) + EPS);
#pragma unroll
        for (int i = 0; i < 4; ++i) { const int col = (lane + 64 * i) * 4; const sc::f32x4 gg = *(const LAS3 sc::f32x4*)(fgv + col);
            *(float4*)(out + (size_t)row * 1024 + col) = make_float4(v[i].x * rstd * gg[0], v[i].y * rstd * gg[1], v[i].z * rstd * gg[2], v[i].w * rstd * gg[3]); }
      }
      __syncthreads();
    }
}

constexpr int N_PHASES = 22;
#define IN_PH(k) (ph_lo <= (k) && (k) < ph_hi)
#define SEAM(k) do { if ((k) + 1 < ph_hi) { XcdBarrier b_; b_.bar = (unsigned*)(p.ws + OFF_BAR); b_.x = xb_xcc_id(); b_.st = (volatile LAS unsigned*)(lds + LDSCTL); xcd_barrier(b_); } } while (0)
#define WSP(T, off) ((T*)(ws + (off)))
template <int l>
DEVI void layer_phases(const Params& p, LAS3 unsigned char* lds, const XcdBarrier& bar, int ph_lo, int ph_hi) {
    unsigned char* ws = p.ws;
    constexpr int pb = 1 + 10 * l;
    const int G = (int)gridDim.x, cid = (int)blockIdx.x;
    constexpr int WFMT = USE_I8 ? 2 : ((l == 1 && WIN1_F8 != 0) ? 1 : 0);
    if (IN_PH(pb + 0)) { ph_norm<0, WFMT, (l == 0)>(lds, (l == 0) ? (const void*)p.in[I_X] : (const void*)WSP(bf16_t, OFF_XB), p.in[I_NORM_MIX_G] + l * 1024, WSP(float, OFF_MOD) + (size_t)(2 * l) * 32 * 3072, WSP(bf16_t, OFF_H), p.in[I_W_IN] + (size_t)l * 1024 * IN_COLS + 3584, nullptr,
                                    WSP(float, OFF_GATES), nullptr, nullptr, nullptr, nullptr, nullptr, WSP(float, OFF_RSH)); SEAM(pb + 0); }
    constexpr bool W8 = (WFMT != 0);
    if (IN_PH(pb + 1)) { pg8::Gemm g{WSP(bf16_t, OFF_H), WSP(bf16_t, OFF_WEIGHTS) + WT_IN + (size_t)l * 5632 * 1024, W8 ? 512 : 1024, W8 ? 512 : 1024, WSP(float, OFF_RSH), WSP(float, OFF_WSTEP) + 3 * l, WSP(float, OFF_WSTEP) + 3 * l}; pg8::StaticOrder S; S.init(TOK, 3584, G, cid);
        pg8::FEpiWinA e{WSP(bf16_t, OFF_QM), WSP(float, OFF_LF), WSP(bf16_t, OFF_HI), WSP(bf16_t, OFF_HG), WSP(bf16_t, OFF_MU), WSP(bf16_t, OFF_MV), WSP(float, OFF_LBT) + l * 512, WFMT == 1 ? 1.0f / (float)(1 << W13_F8) : 1.0f};
        pg8::gemm_phase<pg8::FEpiWinA, pg8::StaticOrder, WFMT>(lds, g, S, e); SEAM(pb + 1); }
    if (IN_PH(pb + 2)) {
        sc::ScanArgs sa{WSP(bf16_t, OFF_QM), WSP(bf16_t, OFF_QM), WSP(float, OFF_LF), WSP(bf16_t, OFF_HI), WSP(bf16_t, OFF_HG), WSP(bf16_t, OFF_MU), WSP(bf16_t, OFF_MV), WSP(float, OFF_GATES),
                        p.in[I_HG_NORM] + l * 512, p.in[I_ML_NORM] + l * 512, p.in[I_CONV_W] + l * 4 * 512, p.in[I_CONV_B] + l * 512,
                        p.in[I_WQ] + (size_t)l * 4 * 128 * 64, p.in[I_WK] + (size_t)l * 4 * 128 * 64, p.in[I_FBIAS] + l * 4, nullptr};
        for (int it = cid; it < 256; it += G) { sc::scan_item(lds, sa, it); __syncthreads(); }
        SEAM(pb + 2); }
    if (IN_PH(pb + 3)) { pg8::Gemm g{WSP(bf16_t, OFF_H), WSP(bf16_t, OFF_WEIGHTS) + WT_IN + (size_t)l * 5632 * 1024 + (W8 ? 3584ull * 512 : 3584ull * 1024), W8 ? 512 : 1024, W8 ? 512 : 1024, WSP(float, OFF_RSH), WSP(float, OFF_WSTEP) + 3 * l + 1, WSP(float, OFF_WSTEP) + 3 * l + 2}; pg8::StaticOrder S; S.init(TOK, 2048, G, cid);
        pg8::FEpiWinG e{WSP(bf16_t, OFF_GA), WSP(bf16_t, OFF_GB), WFMT == 1 ? 1.0f / (float)(1 << W13_F8) : 1.0f};
        pg8::gemm_phase<pg8::FEpiWinG, pg8::StaticOrder, WFMT>(lds, g, S, e); SEAM(pb + 3); }
    if (IN_PH(pb + 4)) {
        pg8::Gemm g{WSP(bf16_t, OFF_QM), WSP(bf16_t, OFF_WEIGHTS) + WT_BRH + (size_t)l * 1024 * 512, 512, 1024}; pg8::BrOrder S; S.init(TOK, 1024, G, cid);
        pg8::FEpiBrG e{WSP(bf16_t, OFF_GA), WSP(bf16_t, OFF_GB), WSP(bf16_t, OFF_MERGED), OUT_F8 != 0, (float)(1 << OUT_A_SH)};
        pg8::gemm_phase<pg8::FEpiBrG, pg8::BrOrder>(lds, g, S, e);
        SEAM(pb + 4); }
    if (IN_PH(pb + 5)) { pg8::Gemm g{WSP(bf16_t, OFF_MERGED), WSP(bf16_t, OFF_WEIGHTS) + WT_OUT + (size_t)l * 1024 * (OUT_F8 ? 512 : 1024), OUT_F8 ? 512 : 1024, OUT_F8 ? 512 : 1024}; pg8::StaticOrder S; S.init(TOK, 1024, G, cid);
        pg8::FEpiResidT<(l == 0)> e{(l == 0) ? (const void*)p.in[I_X] : (const void*)WSP(bf16_t, OFF_XB), WSP(bf16_t, OFF_XB), WSP(float, OFF_MOD) + (size_t)(2 * l) * 32 * 3072, OUT_F8 ? 1.0f / (float)(1 << (W13_F8 + OUT_A_SH)) : 1.0f};
        pg8::gemm_phase<pg8::FEpiResidT<(l == 0)>, pg8::StaticOrder, OUT_F8 != 0>(lds, g, S, e); SEAM(pb + 5); }
    if (l == 0) {
        constexpr int DFMT = USE_I8 ? 2 : (DENSE_F8 ? 1 : 0);
        if (IN_PH(pb + 6)) { ph_norm<1, DFMT, false>(lds, WSP(bf16_t, OFF_XB), p.in[I_NORM_FFN_G] + l * 1024, WSP(float, OFF_MOD) + (size_t)(2 * l + 1) * 32 * 3072, WSP(bf16_t, OFF_H), nullptr, nullptr, nullptr, nullptr, nullptr, nullptr, nullptr, nullptr, WSP(float, OFF_RSH)); SEAM(pb + 6); }
        if (IN_PH(pb + 7)) { pg8::Gemm g{WSP(bf16_t, OFF_H), WSP(bf16_t, OFF_WEIGHTS) + WT_F13, DFMT ? 512 : 1024, DFMT ? 512 : 1024, WSP(float, OFF_RSH), WSP(float, OFF_WSTEP) + 9, WSP(float, OFF_WSTEP) + 10}; pg8::StaticOrder S; S.init(TOK, 5632, G, cid); pg8::FEpiSwigluT<DENSED_F8 != 0> e{WSP(bf16_t, OFF_U), D_FF, 22, DFMT == 1 ? 1.0f / (float)(1 << W13_F8) : 1.0f, 0};
            pg8::gemm_phase<pg8::FEpiSwigluT<DENSED_F8 != 0>, pg8::StaticOrder, DFMT>(lds, g, S, e); SEAM(pb + 7); }
        if (IN_PH(pb + 8)) { pg8::Gemm g{WSP(bf16_t, OFF_U), WSP(bf16_t, OFF_WEIGHTS) + WT_F2, DENSED_F8 ? D_FF / 2 : D_FF, DENSED_F8 ? D_FF / 2 : D_FF}; pg8::StaticOrder S; S.init(TOK, 1024, G, cid);
            pg8::FEpiResidT<false> e{WSP(bf16_t, OFF_XB), WSP(bf16_t, OFF_XB), WSP(float, OFF_MOD) + (size_t)(2 * l + 1) * 32 * 3072, DENSED_F8 ? 1.0f / (float)(1 << W2_F8) : 1.0f};
            pg8::gemm_phase<pg8::FEpiResidT<false>, pg8::StaticOrder, DENSED_F8 != 0>(lds, g, S, e); SEAM(pb + 8); }
        if (IN_PH(pb + 9)) { SEAM(pb + 9); }
    } else {
        constexpr int MFMT = USE_I8 ? 2 : (MOE_F8 ? 1 : 0);
        if (IN_PH(pb + 6)) { ph_norm<2, MFMT, false>(lds, WSP(bf16_t, OFF_XB), p.in[I_NORM_FFN_G] + l * 1024, WSP(float, OFF_MOD) + (size_t)(2 * l + 1) * 32 * 3072, WSP(bf16_t, OFF_H), p.in[I_RW], p.in[I_RB], nullptr,
                                        WSP(int, OFF_RIDX), WSP(float, OFF_RGATE), WSP(int, OFF_RRANK), WSP(int, OFF_MOECNT), WSP(int, OFF_MOECTL) + 1024, WSP(float, OFF_RSH)); SEAM(pb + 6); }
        if (IN_PH(pb + 7)) { const MoeBases mb = moe_bases(WSP(int, OFF_MOECNT)); ph_gather(WSP(bf16_t, OFF_H), WSP(int, OFF_RIDX), WSP(int, OFF_RRANK), WSP(int, OFF_MOECTL) + 1024, mb, WSP(int, OFF_RPOS), WSP(bf16_t, OFF_A2), WSP(float, OFF_RSH), WSP(float, OFF_RSE)); SEAM(pb + 7); }
        if (IN_PH(pb + 8)) { const MoeBases mb = moe_bases(WSP(int, OFF_MOECNT)); pg8::Gemm g{WSP(bf16_t, OFF_A2), WSP(bf16_t, OFF_WEIGHTS) + WT_M13, MFMT ? 512 : 1024, MFMT ? 512 : 1024, WSP(float, OFF_RSE), WSP(float, OFF_WSTEP) + 12, WSP(float, OFF_WSTEP) + 13}; pg8::MoeOrder2 S{mb, 11, G, cid}; pg8::FEpiSwigluT<MOED_F8 != 0> e{WSP(bf16_t, OFF_UE), MOED_F8 ? KD8 : D_FFE, 11, MFMT == 1 ? 1.0f / (float)(1 << W13_F8) : 1.0f, 1};
            pg8::gemm_phase<pg8::FEpiSwigluT<MOED_F8 != 0>, pg8::MoeOrder2, MFMT>(lds, g, S, e); SEAM(pb + 8); }
        if (IN_PH(pb + 9)) { const MoeBases mb = moe_bases(WSP(int, OFF_MOECNT)); pg8::Gemm g{WSP(bf16_t, OFF_UE), WSP(bf16_t, OFF_WEIGHTS) + WT_M2, MOED_F8 ? KD8 / 2 : D_FFE, MOED_F8 ? KD8 / 2 : D_FFE}; pg8::MoeOrder2 S{mb, 4, G, cid}; pg8::FEpiStoreBf e{WSP(bf16_t, OFF_A2), 1024, 4, MOED_F8 ? 1.0f / (float)(1 << W2_F8) : 1.0f};
            pg8::gemm_phase<pg8::FEpiStoreBf, pg8::MoeOrder2, MOED_F8 != 0>(lds, g, S, e); SEAM(pb + 9); }
    }
}
__global__ void __launch_bounds__(512, 2) k_mega(Params p, int ph_lo, int ph_hi) {
    LAS3 unsigned char* lds = (LAS3 unsigned char*)g_shm;
    if ((threadIdx.x & 63) == 0) ((LAS3 int*)(lds + LDS_WAVETAB))[hw_wave_key()] = (int)(threadIdx.x >> 6);
    unsigned char* ws = p.ws;
    if (threadIdx.x < 4) ((LAS3 unsigned*)(lds + LDSCTL))[threadIdx.x] = 0u;
    __syncthreads();
    XcdBarrier bar; bar.bar = (unsigned*)(ws + OFF_BAR); bar.x = 0; bar.st = nullptr;
    if (ph_hi - ph_lo > 1) bar = xcd_barrier_post((unsigned*)(ws + OFF_BAR), (volatile LAS unsigned*)(lds + LDSCTL));
    if (IN_PH(0)) { ph_prologue(p, lds); SEAM(0); }
    layer_phases<0>(p, lds, bar, ph_lo, ph_hi);
    layer_phases<1>(p, lds, bar, ph_lo, ph_hi);
    if (IN_PH(21)) ph_final(lds, WSP(bf16_t, OFF_XB), WSP(float, OFF_MOD) + (size_t)3 * 32 * 3072, WSP(bf16_t, OFF_A2), WSP(int, OFF_RPOS), WSP(float, OFF_RGATE), p.in[I_FINAL_G], p.out);
}
#undef IN_PH
#undef SEAM

#ifndef MK_PER_PHASE
#define MK_PER_PHASE 0
#endif
extern "C" void kernel_launch(void* const* d_in, const int* in_sizes, int n_in, void* d_out, int out_size, void* d_ws, size_t ws_size, hipStream_t stream) {
    (void)in_sizes; (void)out_size; (void)ws_size;
    static int grid = 0;
    if (grid == 0) {
        int dev = 0, cus = 0, per_cu = 0;
        (void)hipGetDevice(&dev); (void)hipDeviceGetAttribute(&cus, hipDeviceAttributeMultiprocessorCount, dev);
        (void)hipFuncSetAttribute((const void*)k_mega, hipFuncAttributeMaxDynamicSharedMemorySize, LDS_BYTES);
        (void)hipOccupancyMaxActiveBlocksPerMultiprocessor(&per_cu, (const void*)k_mega, 512, LDS_BYTES);
        (void)hipGetLastError();
        grid = (cus > 0 && cus < 256) ? cus : 256;
        if (per_cu < 1) grid = 256;
    }
    char* ws = (char*)d_ws;
    (void)hipMemsetAsync(ws + OFF_CTR, 0, 4096 + XCD_BAR_WORDS * 4, stream);
    Params p; memset(&p, 0, sizeof(p));
    for (int i = 0; i < N_IN && i < n_in; ++i) p.in[i] = (const float*)d_in[i];
    p.out = (float*)d_out; p.ws = (unsigned char*)d_ws;
    {
        bf16_t* WT = (bf16_t*)(ws + OFF_WEIGHTS);
        CvtJobs& J = p.J; int nj = 0, tiles = 0;
        auto add = [&](const float* src, bf16_t* dst, int K, int ncols, int ldsrc, int nb, long long sb, int drpb, int mode, int f8 = 0, int dst_ld = 0) {
            CvtJob& q = J.j[nj++]; q.src = src; q.dst = dst; q.K = K; q.ncols = ncols; q.ldsrc = ldsrc; q.nb = nb; q.src_bstride = sb; q.dst_rows_per_batch = drpb; q.mode = mode; q.f8 = f8; q.dst_ld = dst_ld ? dst_ld : K; q.pad = 0; q.tile0 = tiles; tiles += nb * (K / 64) * (ncols / 128); };
        for (int l = 0; l < 2; ++l) {
            const int f = USE_I8 ? I8_FLAG : ((l == 1 && WIN1_F8) ? W13_F8 : 0);
            const float* w = p.in[I_W_IN] + (size_t)l * 1024 * IN_COLS; bf16_t* d = WT + WT_IN + (size_t)l * 5632 * 1024;
            bf16_t* dg = f ? (bf16_t*)((unsigned char*)d + 3584ull * 1024) : d + 3584ull * 1024;
            add(w, d, 1024, 3584, IN_COLS, 1, 0, 0, 0, f);
            add(w + 3592, dg, 1024, 1024, IN_COLS, 1, 0, 0, 1, f);
            add(w + 3592 + 1024, dg, 1024, 1024, IN_COLS, 1, 0, 0, 2, f);
        }
        add(p.in[I_BRH], WT + WT_BRH, 512, 1024, 1024, 2, 512ll * 1024, 1024, 0);
        add(p.in[I_BRM], WT + WT_BRM, 512, 1024, 1024, 2, 512ll * 1024, 1024, 0);
        add(p.in[I_WOUT], WT + WT_OUT, 1024, 1024, 1024, 2, 1024ll * 1024, 1024, 0, OUT_F8 ? W13_F8 : 0);
        add(p.in[I_FW1], WT + WT_F13, 1024, D_FF, D_FF, 1, 0, 0, 1, USE_I8 ? I8_FLAG : (DENSE_F8 ? W13_F8 : 0));
        add(p.in[I_FW3], WT + WT_F13, 1024, D_FF, D_FF, 1, 0, 0, 2, USE_I8 ? I8_FLAG : (DENSE_F8 ? W13_F8 : 0));
        add(p.in[I_FW2], WT + WT_F2, D_FF, 1024, 1024, 1, 0, 0, 0, DENSED_F8 ? W2_F8 : 0);
        add(p.in[I_MW1], WT + WT_M13, 1024, D_FFE, D_FFE, 8, 1024ll * D_FFE, 2816, 1, USE_I8 ? I8_FLAG : (MOE_F8 ? W13_F8 : 0));
        add(p.in[I_MW3], WT + WT_M13, 1024, D_FFE, D_FFE, 8, 1024ll * D_FFE, 2816, 2, USE_I8 ? I8_FLAG : (MOE_F8 ? W13_F8 : 0));
        add(p.in[I_MW2], WT + WT_M2, D_FFE, 1024, 1024, 8, (long long)D_FFE * 1024, 1024, 0, MOED_F8 ? W2_F8 : 0, MOED_F8 ? KD8 : 0);
        for (int q = nj; q < N_CVT; ++q) { J.j[q] = J.j[nj - 1]; J.j[q].tile0 = 0x7fffffff; }
        J.total_tiles = tiles;
    }
    if (MK_PER_PHASE) { for (int ph = 0; ph < N_PHASES; ++ph) hipLaunchKernelGGL(k_mega, dim3(grid), dim3(512), LDS_BYTES, stream, p, ph, ph + 1); }
    else hipLaunchKernelGGL(k_mega, dim3(grid), dim3(512), LDS_BYTES, stream, p, 0, N_PHASES);
}
```

```cpp
#include <hip/hip_runtime.h>
#include <stdint.h>
#include <stddef.h>
#include <string.h>
#define LAS3 __attribute__((address_space(3)))

typedef unsigned short bf16_t;
#define DEVI __device__ __forceinline__

constexpr int D_MODEL = 1024, BATCH = 32, SEQL = 2048, TOK = BATCH * SEQL;
constexpr int IN_COLS = 5640;
constexpr int D_FF = 2816, N_EXP = 8, D_FFE = 1408;
constexpr float EPS = 1e-6f;
constexpr int MOE_ROWS = 2 * TOK + N_EXP * 256;

constexpr size_t MiB = 1024ull * 1024ull;
constexpr size_t OFF_MISC = 0;
constexpr size_t OFF_MOD = OFF_MISC + 64 * 1024;
constexpr size_t OFF_GATES = OFF_MISC + 2 * MiB;
constexpr size_t OFF_RIDX = OFF_MISC + 4 * MiB;
constexpr size_t OFF_RGATE = OFF_MISC + 5 * MiB;
constexpr size_t OFF_RRANK = OFF_MISC + 6 * MiB;
constexpr size_t OFF_RPOS = OFF_MISC + 7 * MiB;
constexpr size_t OFF_MOECTL = OFF_MISC + 8 * MiB;
constexpr size_t OFF_WEIGHTS = 16 * MiB;
constexpr size_t OFF_H = OFF_WEIGHTS + 120 * MiB;
constexpr size_t OFF_QM = OFF_H + 128 * MiB;
constexpr size_t OFF_LF = OFF_QM + 128 * MiB;
constexpr size_t OFF_HI = OFF_LF + 128 * MiB;
constexpr size_t OFF_HG = OFF_HI + 64 * MiB;
constexpr size_t OFF_MU = OFF_HG + 64 * MiB;
constexpr size_t OFF_MV = OFF_MU + 64 * MiB;
constexpr size_t OFF_UC = OFF_MV + 64 * MiB;
constexpr size_t OFF_QQ = OFF_UC + 64 * MiB;
constexpr size_t OFF_KK = OFF_QQ + 32 * MiB;
constexpr size_t OFF_END = OFF_KK + 32 * MiB;
constexpr size_t OFF_XB = OFF_UC;
constexpr size_t OFF_GA = OFF_LF;
constexpr size_t OFF_GB = OFF_HI;
constexpr size_t OFF_MERGED = OFF_MU;
constexpr size_t OFF_U = OFF_QM;
constexpr size_t OFF_A2 = OFF_QM;
constexpr size_t OFF_UE = OFF_QM + 260 * MiB;
static_assert(OFF_UE + (size_t)MOE_ROWS * D_FFE * 2 <= OFF_END, "moe overlay");
static_assert(OFF_END <= 1024 * MiB, "ws");

typedef __bf16 nbf16x2 __attribute__((ext_vector_type(2)));
typedef float nf32x2 __attribute__((ext_vector_type(2)));
DEVI unsigned cvt2bf(float lo, float hi) { nf32x2 f = {lo, hi}; return __builtin_bit_cast(unsigned, __builtin_convertvector(f, nbf16x2)); }
DEVI bf16_t f2bf(float f) { return (bf16_t)(cvt2bf(f, 0.f) & 0xffffu); }
DEVI float bf2f(bf16_t b) { return __uint_as_float(((unsigned)b) << 16); }
DEVI float sigmoidf_(float z) { return __builtin_amdgcn_rcpf(1.0f + __expf(-z)); }
DEVI float siluf_(float z) { return z * __builtin_amdgcn_rcpf(1.0f + __expf(-z)); }
template <int CTRL, int ROWMASK> DEVI float dpp_mov(float old, float v) { return __int_as_float(__builtin_amdgcn_update_dpp(__float_as_int(old), __float_as_int(v), CTRL, ROWMASK, 0xf, false)); }
DEVI float wave_sum(float v) {
    v += dpp_mov<0xB1, 0xf>(0.f, v);
    v += dpp_mov<0x4E, 0xf>(0.f, v);
    v += dpp_mov<0x141, 0xf>(0.f, v);
    v += dpp_mov<0x140, 0xf>(0.f, v);
    v += dpp_mov<0x142, 0xa>(0.f, v);
    v += dpp_mov<0x143, 0xc>(0.f, v);
    return __int_as_float(__builtin_amdgcn_readlane(__float_as_int(v), 63));
}
DEVI float wave_max(float v) {
    v = fmaxf(v, dpp_mov<0xB1, 0xf>(v, v));
    v = fmaxf(v, dpp_mov<0x4E, 0xf>(v, v));
    v = fmaxf(v, dpp_mov<0x141, 0xf>(v, v));
    v = fmaxf(v, dpp_mov<0x140, 0xf>(v, v));
    v = fmaxf(v, dpp_mov<0x142, 0xa>(v, v));
    v = fmaxf(v, dpp_mov<0x143, 0xc>(v, v));
    return __int_as_float(__builtin_amdgcn_readlane(__float_as_int(v), 63));
}
DEVI float wave_sum8(const float (&x)[8], int lane) {
    const bool b2 = lane & 4, b1 = lane & 2, b0 = lane & 1;
    float r1[4], r2[2];
#pragma unroll
    for (int k = 0; k < 4; ++k) r1[k] = (b2 ? x[4 + k] : x[k]) + dpp_mov<0x141, 0xf>(0.f, b2 ? x[k] : x[4 + k]);
#pragma unroll
    for (int k = 0; k < 2; ++k) r2[k] = (b1 ? r1[2 + k] : r1[k]) + dpp_mov<0x4E, 0xf>(0.f, b1 ? r1[k] : r1[2 + k]);
    float r = (b0 ? r2[1] : r2[0]) + dpp_mov<0xB1, 0xf>(0.f, b0 ? r2[0] : r2[1]);
    r += dpp_mov<0x128, 0xf>(0.f, r);
    r += __shfl_xor(r, 16); r += __shfl_xor(r, 32);
    return r;
}
DEVI float wave_scan_sum(float v) {
    v += dpp_mov<0x111, 0xf>(0.f, v); v += dpp_mov<0x112, 0xf>(0.f, v); v += dpp_mov<0x114, 0xf>(0.f, v); v += dpp_mov<0x118, 0xf>(0.f, v);
    v += dpp_mov<0x142, 0xa>(0.f, v); v += dpp_mov<0x143, 0xc>(0.f, v);
    return v;
}
DEVI float wave_scan_max(float v) {
    const float ninf = -3.0e38f;
    v = fmaxf(v, dpp_mov<0x111, 0xf>(ninf, v)); v = fmaxf(v, dpp_mov<0x112, 0xf>(ninf, v)); v = fmaxf(v, dpp_mov<0x114, 0xf>(ninf, v)); v = fmaxf(v, dpp_mov<0x118, 0xf>(ninf, v));
    v = fmaxf(v, dpp_mov<0x142, 0xa>(ninf, v)); v = fmaxf(v, dpp_mov<0x143, 0xc>(ninf, v));
    return v;
}
DEVI float lane63(float v) { return __int_as_float(__builtin_amdgcn_readlane(__float_as_int(v), 63)); }
DEVI unsigned pack_i8x4(float a, float b, float c, float d) {
    const unsigned ua = __float_as_uint(a + 12582912.0f), ub = __float_as_uint(b + 12582912.0f), uc = __float_as_uint(c + 12582912.0f), ud = __float_as_uint(d + 12582912.0f);
    return __builtin_amdgcn_perm(ub, ua, 0x0c0c0400u) | __builtin_amdgcn_perm(ud, uc, 0x04000c0cu);
}
DEVI float sat8(float x) { return __builtin_amdgcn_fmed3f(x, -448.0f, 448.0f); }
DEVI float tof(float v) { return v; }
DEVI float tof(bf16_t v) { return bf2f(v); }

extern __shared__ __attribute__((aligned(16))) unsigned char g_shm[];
constexpr int LDS_WAVETAB = 128 * 1024 + 64;
DEVI unsigned hw_wave_key() { return (unsigned)__builtin_amdgcn_s_getreg((5 << 11) | 4) & 63u; }
DEVI int lane_id_() { return (int)__builtin_amdgcn_mbcnt_hi(~0u, __builtin_amdgcn_mbcnt_lo(~0u, 0u)); }
DEVI int wave_id_() { return __builtin_amdgcn_readfirstlane(((const LAS3 int*)((LAS3 unsigned char*)g_shm + LDS_WAVETAB))[hw_wave_key()]); }
DEVI int tid_() { return wave_id_() * 64 + lane_id_(); }

namespace pg8 {
#define PG8_LAS __attribute__((address_space(3)))
typedef short bf16x8 __attribute__((ext_vector_type(8)));
typedef float f32x4 __attribute__((ext_vector_type(4)));
typedef unsigned u32x4 __attribute__((ext_vector_type(4)));
constexpr int BM = 256, BK = 64, HALF = 128, HTB = HALF * BK * 2, STAGE_BYTES = 8 * HTB, NXCD = 8, WGM = 8;
__host__ __device__ __forceinline__ int lds_byte(int r, int c) { const int st = (r >> 4) * 2 + (c >> 5), rr = r & 15, cc = c & 31, ob = rr * 64 + cc * 2; return st * 1024 + (ob ^ (((ob >> 9) & 1) << 5)); }
__host__ __device__ __forceinline__ void stage_rc(int b, int& R, int& C) { const int st = b / 1024, sb = b % 1024, swz = sb ^ (((sb >> 9) & 1) << 5); R = (st >> 1) * 16 + swz / 64; C = (st & 1) * 32 + (swz % 64) / 2; }
__host__ __device__ __forceinline__ int perm32(int rho) { const int n = rho >> 4, i = rho & 15; return 8 * (i >> 2) + 4 * n + (i & 3); }
struct Unit { int pm, pn, acol; };
struct Gemm { const bf16_t* A; const bf16_t* Bt; int K, lda; const float* rs = nullptr; const float* ws0 = nullptr; const float* ws1 = nullptr; };
struct StaticOrder {
    int nM, nN, nwg, G, c;
    __device__ void init(int M, int N, int G_, int c_) { nM = M / BM; nN = N / BM; nwg = nM * nN; G = G_; c = c_; }
    __device__ bool next(int i, Unit& u) const {
        const long L = (long)i * G + c; if (L >= nwg) return false;
        int wgid = (int)L; { const int q = nwg / NXCD, r = nwg % NXCD, xcd = wgid % NXCD, off = wgid / NXCD; wgid = (xcd < r ? xcd * (q + 1) : r * (q + 1) + (xcd - r) * q) + off; }
        const int nig = WGM * nN, gid = wgid / nig, fm = gid * WGM, gsz = (nM - fm) < WGM ? (nM - fm) : WGM;
        u.pm = fm + ((wgid % nig) % gsz); u.pn = (wgid % nig) / gsz; u.acol = 0; return true;
    }
};
struct BrOrder : StaticOrder {
    __device__ bool next(int i, Unit& u) const { if (!StaticOrder::next(i >> 1, u)) return false; if (i & 1) { u.pn += 8; u.acol = 1024; } return true; }
};
struct MoeOrder {
    const int* ctl; int nN, G, c;
    __device__ bool next(int i, Unit& u) const {
        const int nt = __builtin_amdgcn_readfirstlane(ctl[128]); const long L = (long)i * G + c; if (L >= (long)nt * nN) return false;
        const int pm = (int)(L / nN), pnl = (int)(L % nN); u.pm = pm; u.pn = __builtin_amdgcn_readfirstlane(ctl[4096 + pm]) * nN + pnl; u.acol = 0; return true;
    }
};
__device__ __forceinline__ unsigned cvt_pk_bf16(float lo, float hi) { return cvt2bf(lo, hi); }
__device__ __forceinline__ u32x4 pack8(const f32x4 a, const f32x4 b) { u32x4 w; w.x = cvt_pk_bf16(a[0], a[1]); w.y = cvt_pk_bf16(a[2], a[3]); w.z = cvt_pk_bf16(b[0], b[1]); w.w = cvt_pk_bf16(b[2], b[3]); return w; }
__device__ __forceinline__ void unpack8(const u32x4 w, f32x4& a, f32x4& b) {
    a[0] = __uint_as_float(w.x << 16); a[1] = __uint_as_float(w.x & 0xffff0000u); a[2] = __uint_as_float(w.y << 16); a[3] = __uint_as_float(w.y & 0xffff0000u);
    b[0] = __uint_as_float(w.z << 16); b[1] = __uint_as_float(w.z & 0xffff0000u); b[2] = __uint_as_float(w.w << 16); b[3] = __uint_as_float(w.w & 0xffff0000u); }

typedef int i32x4 __attribute__((ext_vector_type(4)));
typedef int i32x8 __attribute__((ext_vector_type(8)));
__device__ __forceinline__ i32x8 cat8(bf16x8 lo, bf16x8 hi) { return __builtin_shufflevector(__builtin_bit_cast(i32x4, lo), __builtin_bit_cast(i32x4, hi), 0, 1, 2, 3, 4, 5, 6, 7); }
__device__ __forceinline__ const char* uni(const char* p) { unsigned long long v = (unsigned long long)p; asm volatile("" : "+s"(v)); return (const char*)v; }
template <class Epi, class Sched, int FMT = 0>
__device__ __forceinline__ void gemm_phase(PG8_LAS unsigned char* lds, const Gemm g, const Sched& S, const Epi& E) {
    constexpr bool FP8 = (FMT == 1);
    const int tid = tid_(), wid = __builtin_amdgcn_readfirstlane(tid >> 6), lane = tid & 63, wr = wid >> 2, wc = wid & 3, fr = lane & 15, fq = lane >> 4;
    const int K = g.K, nt = K / BK, lda = g.lda;
    unsigned voffA[2], voffB[2];
#pragma unroll
    for (int i = 0; i < 2; ++i) { int R, C; stage_rc(tid * 16 + i * 8192, R, C); const int Rb = Epi::PERM ? ((R & ~31) + perm32(R & 31)) : R;
        voffA[i] = (unsigned)(R * lda + C) * 2u; voffB[i] = (unsigned)(Rb * K + C) * 2u; }
    constexpr unsigned kstep = (unsigned)(BK * 2);
    const unsigned hstepA = (unsigned)HALF * (unsigned)lda * 2u, hstepB = (unsigned)HALF * (unsigned)K * 2u;
    const size_t tstepA = 2 * (size_t)hstepA, tstepB = 2 * (size_t)hstepB;
    const unsigned ldsw = (unsigned)wid * 1024u;
    const int aoff = lds_byte(wr * 64 + fr, fq * 8), boff = lds_byte(wc * 32 + fr, fq * 8);
#define PG8_SA(b, h) (((b) * 2 + (h)) * HTB)
#define PG8_SB(b, h) ((4 + (b) * 2 + (h)) * HTB)
#define PG8_STAGE(bufoff, gbase, voff) do { _Pragma("unroll") for (int _i = 0; _i < 2; ++_i) \
        __builtin_amdgcn_global_load_lds((const unsigned*)((const char*)(gbase) + (voff)[_i]), (PG8_LAS unsigned*)(lds + (bufoff) + ldsw + _i * 8192), 16, 0, 0); } while (0)
#define PG8_LDA(dst, b, h) do { _Pragma("unroll") for (int m = 0; m < 4; ++m) { \
        if constexpr (FP8) dst##8[m] = cat8(*(const PG8_LAS bf16x8*)(lds + PG8_SA(b, h) + aoff + m * 2048), *(const PG8_LAS bf16x8*)(lds + PG8_SA(b, h) + aoff + m * 2048 + 1024)); \
        else { _Pragma("unroll") for (int k = 0; k < 2; ++k) dst[m][k] = *(const PG8_LAS bf16x8*)(lds + PG8_SA(b, h) + aoff + m * 2048 + k * 1024); } } } while (0)
#define PG8_LDB(dst, b, h) do { _Pragma("unroll") for (int n = 0; n < 2; ++n) { \
        if constexpr (FP8) dst##8[n] = cat8(*(const PG8_LAS bf16x8*)(lds + PG8_SB(b, h) + boff + n * 2048), *(const PG8_LAS bf16x8*)(lds + PG8_SB(b, h) + boff + n * 2048 + 1024)); \
        else { _Pragma("unroll") for (int k = 0; k < 2; ++k) dst[n][k] = *(const PG8_LAS bf16x8*)(lds + PG8_SB(b, h) + boff + n * 2048 + k * 1024); } } } while (0)
#define PG8_MMA(ai, bj, At, Bt) do { __builtin_amdgcn_s_setprio(1); _Pragma("unroll") for (int m = 0; m < 4; ++m) _Pragma("unroll") for (int n = 0; n < 2; ++n) { \
        if constexpr (FP8) asm volatile("v_mfma_f32_16x16x128_f8f6f4 %0, %1, %2, %0" : "+v"(acc[ai][bj][m][n]) : "v"(Bt##8[n]), "v"(At##8[m]));   \
        else if constexpr (FMT == 2) { _Pragma("unroll") for (int k = 0; k < 2; ++k) acc[ai][bj][m][n] = __builtin_bit_cast(f32x4, __builtin_amdgcn_mfma_i32_16x16x64_i8(__builtin_bit_cast(i32x4, Bt[n][k]), __builtin_bit_cast(i32x4, At[m][k]), __builtin_bit_cast(i32x4, acc[ai][bj][m][n]), 0, 0, 0)); } \
        else { _Pragma("unroll") for (int k = 0; k < 2; ++k) acc[ai][bj][m][n] = __builtin_amdgcn_mfma_f32_16x16x32_bf16(Bt[n][k], At[m][k], acc[ai][bj][m][n], 0, 0, 0); } } \
        __builtin_amdgcn_s_setprio(0); } while (0)
#define PG8_WAIT_V(n) asm volatile("s_waitcnt vmcnt(" #n ")" ::: "memory")
#define PG8_WAIT_L(n) asm volatile("s_waitcnt lgkmcnt(" #n ")" ::: "memory")
#define PG8_BAR __builtin_amdgcn_s_barrier()
#define PG8_SCHED __builtin_amdgcn_sched_barrier(0)
    Unit cur, nxt; int ui = 0;
    if (!S.next(0, cur)) return;
    f32x4 acc[2][2][4][2];
#pragma unroll
    for (int a = 0; a < 2; ++a)
#pragma unroll
        for (int b = 0; b < 2; ++b)
#pragma unroll
            for (int m = 0; m < 4; ++m)
#pragma unroll
                for (int n = 0; n < 2; ++n) acc[a][b][m][n] = (f32x4){0.f, 0.f, 0.f, 0.f};
    bf16x8 At[4][2], B0[2][2], B1[2][2];
    i32x8 At8[4], B08[2], B18[2];
    const char* cA = (const char*)g.A + (size_t)cur.pm * tstepA + cur.acol; const char* cB = (const char*)g.Bt + (size_t)cur.pn * tstepB;
    PG8_STAGE(PG8_SB(0, 0), cB, voffB); PG8_STAGE(PG8_SA(0, 0), cA, voffA); PG8_STAGE(PG8_SB(0, 1), cB + hstepB, voffB); PG8_STAGE(PG8_SA(0, 1), cA + hstepA, voffA);
    if (wr == 1) PG8_BAR;
    PG8_WAIT_V(4); PG8_BAR;
    PG8_STAGE(PG8_SB(1, 0), cB + kstep, voffB); PG8_STAGE(PG8_SA(1, 0), cA + kstep, voffA); PG8_STAGE(PG8_SB(1, 1), cB + hstepB + kstep, voffB);
    PG8_WAIT_V(6); PG8_BAR;
    for (;;) {
        const bool has_next = S.next(ui + 1, nxt);
        const char* nA = has_next ? (const char*)g.A + (size_t)nxt.pm * tstepA + nxt.acol : cA; const char* nB = has_next ? (const char*)g.Bt + (size_t)nxt.pn * tstepB : cB;
#pragma unroll 1
        for (int t = 0; t < nt; t += 2) {
            const bool last = (t == nt - 2);
            const char* a1 = uni(cA + (size_t)(t + 1) * kstep);
            const char* a2 = uni(last ? nA : cA + (size_t)(t + 2) * kstep); const char* b2 = uni(last ? nB : cB + (size_t)(t + 2) * kstep);
            const char* a3 = a2 + kstep; const char* b3 = b2 + kstep;
            PG8_LDB(B0, 0, 0); PG8_SCHED; PG8_LDA(At, 0, 0); PG8_STAGE(PG8_SA(1, 1), a1 + hstepA, voffA);
            PG8_WAIT_L(8); PG8_BAR; PG8_WAIT_L(0); PG8_MMA(0, 0, At, B0); PG8_BAR; PG8_SCHED;
            PG8_LDB(B1, 0, 1); PG8_STAGE(PG8_SB(0, 0), b2, voffB);
            PG8_BAR; PG8_WAIT_L(0); PG8_MMA(0, 1, At, B1); PG8_BAR;
            PG8_LDA(At, 0, 1); PG8_STAGE(PG8_SA(0, 0), a2, voffA);
            PG8_BAR; PG8_WAIT_L(0); PG8_MMA(1, 0, At, B0); PG8_BAR; PG8_SCHED;
            PG8_STAGE(PG8_SB(0, 1), b2 + hstepB, voffB);
            PG8_WAIT_V(6); PG8_BAR; PG8_MMA(1, 1, At, B1); PG8_BAR;
            PG8_LDB(B0, 1, 0); PG8_SCHED; PG8_LDA(At, 1, 0); PG8_STAGE(PG8_SA(0, 1), a2 + hstepA, voffA);
            PG8_WAIT_L(8); PG8_BAR; PG8_WAIT_L(0); PG8_MMA(0, 0, At, B0); PG8_BAR; PG8_SCHED;
            PG8_LDB(B1, 1, 1); PG8_STAGE(PG8_SB(1, 0), b3, voffB);
            PG8_BAR; PG8_WAIT_L(0); PG8_MMA(0, 1, At, B1); PG8_BAR;
            PG8_LDA(At, 1, 1); PG8_STAGE(PG8_SA(1, 0), a3, voffA);
            PG8_BAR; PG8_WAIT_L(0); PG8_MMA(1, 0, At, B0); PG8_BAR; PG8_SCHED;
            PG8_STAGE(PG8_SB(1, 1), b3 + hstepB, voffB);
            PG8_WAIT_V(6); PG8_BAR; PG8_MMA(1, 1, At, B1); PG8_BAR;
        }
        if constexpr (FP8) asm volatile("s_nop 15\n\ts_nop 15" ::: "memory");
        if constexpr (FMT == 2) {
            const float w0 = *g.ws0, w1 = *g.ws1;
#pragma unroll
            for (int a = 0; a < 2; ++a)
#pragma unroll
                for (int m = 0; m < 4; ++m) { const float r = g.rs[(size_t)cur.pm * BM + a * HALF + wr * 64 + m * 16 + fr]; const float s0 = r * w0, s1 = r * w1;
#pragma unroll
                    for (int n = 0; n < 2; ++n)
#pragma unroll
                        for (int j = 0; j < 4; ++j) { acc[a][0][m][n][j] = (float)__float_as_int(acc[a][0][m][n][j]) * s0; acc[a][1][m][n][j] = (float)__float_as_int(acc[a][1][m][n][j]) * s1; } }
        }
        E(acc, cur, wr, wc, fr, fq);
        if (!has_next) break;
        bool keep = false; if constexpr (Epi::KEEP) keep = E.keep(cur);
        if (!keep)
#pragma unroll
        for (int a = 0; a < 2; ++a)
#pragma unroll
            for (int b = 0; b < 2; ++b)
#pragma unroll
                for (int m = 0; m < 4; ++m)
#pragma unroll
                    for (int n = 0; n < 2; ++n) acc[a][b][m][n] = (f32x4){0.f, 0.f, 0.f, 0.f};
        cur = nxt; cA = nA; cB = nB; ++ui;
    }
    PG8_WAIT_V(0);
    if (wr == 0) PG8_BAR;
    PG8_BAR;
#undef PG8_SA
#undef PG8_SB
#undef PG8_STAGE
#undef PG8_LDA
#undef PG8_LDB
#undef PG8_MMA
#undef PG8_WAIT_V
#undef PG8_WAIT_L
#undef PG8_BAR
#undef PG8_SCHED
}

#define EPI_LOOP_AM _Pragma("unroll") for (int ai = 0; ai < 2; ++ai) _Pragma("unroll") for (int m = 0; m < 4; ++m)
__device__ __forceinline__ f32x4 silu4(f32x4 v) { f32x4 o; _Pragma("unroll") for (int j = 0; j < 4; ++j) o[j] = v[j] * __builtin_amdgcn_rcpf(1.0f + __expf(-v[j])); return o; }
__device__ __forceinline__ f32x4 sigm4(f32x4 v) { f32x4 o; _Pragma("unroll") for (int j = 0; j < 4; ++j) o[j] = __builtin_amdgcn_rcpf(1.0f + __expf(-v[j])); return o; }
struct FEpiWinA {
    static constexpr bool PERM = true, KEEP = false;
    bf16_t* QM; float* LF; bf16_t* HI; bf16_t* HG; bf16_t* MU; bf16_t* MV; const float* lb; float sc;
    __device__ __forceinline__ void operator()(const f32x4 (&acc)[2][2][4][2], const Unit& u, int wr, int wc, int fr, int fq) const {
        const int row0 = u.pm * BM + wr * 64 + fr, grp = u.pn >> 1, cb = (u.pn & 1) * 256 + wc * 32 + 8 * fq;
        if (grp == 1) {
            f32x4 l0[2], l1[2];
#pragma unroll
            for (int bj = 0; bj < 2; ++bj) { l0[bj] = *(const f32x4*)(lb + cb + bj * HALF); l1[bj] = *(const f32x4*)(lb + cb + bj * HALF + 4); }
            EPI_LOOP_AM { float* rp = LF + (size_t)(row0 + ai * HALF + m * 16) * 512 + cb;
#pragma unroll
                for (int bj = 0; bj < 2; ++bj) { f32x4 o0, o1;
#pragma unroll
                    for (int j = 0; j < 4; ++j) { const float z0 = fmaxf(acc[ai][bj][m][0][j] * sc, -80.f), z1 = fmaxf(acc[ai][bj][m][1][j] * sc, -80.f);
                        o0[j] = __logf(l0[bj][j] + (1.f - l0[bj][j]) * __builtin_amdgcn_rcpf(1.0f + __expf(-z0))); o1[j] = __logf(l1[bj][j] + (1.f - l1[bj][j]) * __builtin_amdgcn_rcpf(1.0f + __expf(-z1))); }
                    __builtin_nontemporal_store(o0, (f32x4*)(rp + bj * HALF)); __builtin_nontemporal_store(o1, (f32x4*)(rp + bj * HALF + 4)); } }
        } else if (grp == 0 || grp == 6) {
            bf16_t* base = QM + (grp == 6 ? 512 : 0);
            EPI_LOOP_AM { bf16_t* rp = base + (size_t)(row0 + ai * HALF + m * 16) * 1024 + cb;
#pragma unroll
                for (int bj = 0; bj < 2; ++bj) { const f32x4 a = acc[ai][bj][m][0] * sc, b = acc[ai][bj][m][1] * sc;
                    __builtin_nontemporal_store((grp == 0) ? pack8(silu4(a), silu4(b)) : pack8(sigm4(a), sigm4(b)), (u32x4*)(rp + bj * HALF)); } }
        } else {
            bf16_t* base = (grp == 2) ? HI : (grp == 3) ? HG : (grp == 4) ? MU : MV;
            EPI_LOOP_AM { bf16_t* rp = base + (size_t)(row0 + ai * HALF + m * 16) * 512 + cb;
#pragma unroll
                for (int bj = 0; bj < 2; ++bj) { const f32x4 a = acc[ai][bj][m][0] * sc, b = acc[ai][bj][m][1] * sc;
                    __builtin_nontemporal_store((grp == 3) ? pack8(silu4(a), silu4(b)) : pack8(a, b), (u32x4*)(rp + bj * HALF)); } }
        }
    }
};
struct FEpiWinG {
    static constexpr bool PERM = true, KEEP = false;
    bf16_t* GA; bf16_t* GB; float sc;
    __device__ __forceinline__ void operator()(const f32x4 (&acc)[2][2][4][2], const Unit& u, int wr, int wc, int fr, int fq) const {
        const int row0 = u.pm * BM + wr * 64 + fr, cb = (u.pn & 7) * 128 + wc * 32 + 8 * fq;
        EPI_LOOP_AM { const size_t ro = (size_t)(row0 + ai * HALF + m * 16) * 1024 + cb; f32x4 ra[2], sb[2];
#pragma unroll
            for (int n = 0; n < 2; ++n)
#pragma unroll
                for (int j = 0; j < 4; ++j) { const float ea = __expf(-acc[ai][0][m][n][j] * sc), eb = __expf(-acc[ai][1][m][n][j] * sc); const float s = __builtin_amdgcn_rcpf(1.0f + eb); sb[n][j] = s; ra[n][j] = (1.0f + eb) * __builtin_amdgcn_rcpf(1.0f + ea); }
            __builtin_nontemporal_store(pack8(ra[0], ra[1]), (u32x4*)(GA + ro)); __builtin_nontemporal_store(pack8(sb[0], sb[1]), (u32x4*)(GB + ro)); }
    }
};
struct FEpiBrG {
    static constexpr bool PERM = true, KEEP = true;
    const bf16_t* RA; const bf16_t* SB; bf16_t* Mg; bool M8; float msc;
    __device__ __forceinline__ bool keep(const Unit& u) const { return u.pn < 8; }
    __device__ __forceinline__ void operator()(f32x4 (&acc)[2][2][4][2], const Unit& u, int wr, int wc, int fr, int fq) const {
        const bool first = u.pn < 8; const int row0 = u.pm * BM + wr * 64 + fr, cb = (u.pn & 7) * 256 + wc * 32 + 8 * fq; const bf16_t* Gp = first ? RA : SB;
        u32x4 gq[2][4][2];
#pragma unroll
        for (int ai = 0; ai < 2; ++ai)
#pragma unroll
            for (int m = 0; m < 4; ++m)
#pragma unroll
                for (int bj = 0; bj < 2; ++bj) gq[ai][m][bj] = *(const u32x4*)(Gp + (size_t)(row0 + ai * HALF + m * 16) * 1024 + cb + bj * HALF);
#pragma unroll
        for (int ai = 0; ai < 2; ++ai) {
#pragma unroll
            for (int m = 0; m < 4; ++m)
#pragma unroll
                for (int bj = 0; bj < 2; ++bj) { f32x4 g0, g1; unpack8(gq[ai][m][bj], g0, g1); acc[ai][bj][m][0] *= g0; acc[ai][bj][m][1] *= g1;
                    if (!first) {
                        if (M8) { const f32x4 a = acc[ai][bj][m][0] * msc, b = acc[ai][bj][m][1] * msc; unsigned q0 = 0u, q1 = 0u;
                            q0 = __builtin_amdgcn_cvt_pk_fp8_f32(sat8(a[0]), sat8(a[1]), q0, false); q0 = __builtin_amdgcn_cvt_pk_fp8_f32(sat8(a[2]), sat8(a[3]), q0, true);
                            q1 = __builtin_amdgcn_cvt_pk_fp8_f32(sat8(b[0]), sat8(b[1]), q1, false); q1 = __builtin_amdgcn_cvt_pk_fp8_f32(sat8(b[2]), sat8(b[3]), q1, true);
                            *(uint2*)((unsigned char*)Mg + (size_t)(row0 + ai * HALF + m * 16) * 1024 + cb + bj * HALF) = make_uint2(q0, q1); }
                        else __builtin_nontemporal_store(pack8(acc[ai][bj][m][0], acc[ai][bj][m][1]), (u32x4*)(Mg + (size_t)(row0 + ai * HALF + m * 16) * 1024 + cb + bj * HALF)); } }
        }
    }
};
template <bool XIN_F32> struct FEpiResidT {
    static constexpr bool PERM = true, KEEP = false;
    const void* xin; bf16_t* xout; const float* mod; float sc;
    __device__ __forceinline__ void operator()(const f32x4 (&acc)[2][2][4][2], const Unit& u, int wr, int wc, int fr, int fq) const {
        const int row0 = u.pm * BM + wr * 64 + fr, cb = u.pn * BM + wc * 32 + 8 * fq;
        const float* gp = mod + (size_t)(u.pm >> 3) * 3072 + 2048 + cb;
        f32x4 gv[2][2];
#pragma unroll
        for (int bj = 0; bj < 2; ++bj)
#pragma unroll
            for (int n = 0; n < 2; ++n) gv[bj][n] = *(const f32x4*)(gp + bj * HALF + 4 * n) * sc;
#pragma unroll
        for (int ai = 0; ai < 2; ++ai) {
            f32x4 xv[4][2][2];
#pragma unroll
            for (int m = 0; m < 4; ++m)
#pragma unroll
                for (int bj = 0; bj < 2; ++bj) { const size_t ro = (size_t)(row0 + ai * HALF + m * 16) * 1024 + cb + bj * HALF;
                    if (XIN_F32) { xv[m][bj][0] = *(const f32x4*)((const float*)xin + ro); xv[m][bj][1] = *(const f32x4*)((const float*)xin + ro + 4); }
                    else unpack8(*(const u32x4*)((const bf16_t*)xin + ro), xv[m][bj][0], xv[m][bj][1]); }
#pragma unroll
            for (int m = 0; m < 4; ++m)
#pragma unroll
                for (int bj = 0; bj < 2; ++bj) { const size_t ro = (size_t)(row0 + ai * HALF + m * 16) * 1024 + cb + bj * HALF;
                    __builtin_nontemporal_store(pack8(xv[m][bj][0] + gv[bj][0] * acc[ai][bj][m][0], xv[m][bj][1] + gv[bj][1] * acc[ai][bj][m][1]), (u32x4*)(xout + ro)); }
        }
    }
};
template <bool OUT8> struct FEpiSwigluT {
    static constexpr bool PERM = true, KEEP = false;
    bf16_t* U; int ldu, nN; float sc; int padz;
    __device__ __forceinline__ void operator()(const f32x4 (&acc)[2][2][4][2], const Unit& u, int wr, int wc, int fr, int fq) const {
        const int row0 = u.pm * BM + wr * 64 + fr, pnl = u.pn % nN, cb = pnl * 128 + wc * 32 + 8 * fq;
        EPI_LOOP_AM { const f32x4 o0 = silu4(acc[ai][0][m][0] * sc) * (acc[ai][1][m][0] * sc), o1 = silu4(acc[ai][0][m][1] * sc) * (acc[ai][1][m][1] * sc);
            if (OUT8) { unsigned q0 = 0u, q1 = 0u; q0 = __builtin_amdgcn_cvt_pk_fp8_f32(sat8(o0[0]), sat8(o0[1]), q0, false); q0 = __builtin_amdgcn_cvt_pk_fp8_f32(sat8(o0[2]), sat8(o0[3]), q0, true);
                q1 = __builtin_amdgcn_cvt_pk_fp8_f32(sat8(o1[0]), sat8(o1[1]), q1, false); q1 = __builtin_amdgcn_cvt_pk_fp8_f32(sat8(o1[2]), sat8(o1[3]), q1, true);
                unsigned char* rp = (unsigned char*)U + (size_t)(row0 + ai * HALF + m * 16) * ldu + cb; *(uint2*)rp = make_uint2(q0, q1);
                if (padz && pnl == nN - 1) *(uint2*)(rp + 128) = make_uint2(0u, 0u); }
            else __builtin_nontemporal_store(pack8(o0, o1), (u32x4*)(U + (size_t)(row0 + ai * HALF + m * 16) * ldu + cb)); }
    }
};
typedef FEpiSwigluT<false> FEpiSwiglu;
struct FEpiStoreBf {
    static constexpr bool PERM = true, KEEP = false;
    bf16_t* O; int ldo, nN; float sc;
    __device__ __forceinline__ void operator()(const f32x4 (&acc)[2][2][4][2], const Unit& u, int wr, int wc, int fr, int fq) const {
        const int row0 = u.pm * BM + wr * 64 + fr, cb = (u.pn % nN) * 256 + wc * 32 + 8 * fq;
        EPI_LOOP_AM { bf16_t* rp = O + (size_t)(row0 + ai * HALF + m * 16) * ldo + cb;
#pragma unroll
            for (int bj = 0; bj < 2; ++bj) __builtin_nontemporal_store(pack8(acc[ai][bj][m][0] * sc, acc[ai][bj][m][1] * sc), (u32x4*)(rp + bj * HALF)); }
    }
};
}

struct CvtJob { const float* src; bf16_t* dst; long long src_bstride; int K, ncols, ldsrc, nb, dst_rows_per_batch, mode, tile0, f8, dst_ld, pad; };
static_assert(sizeof(CvtJob) == 64 && offsetof(CvtJob, K) == 24 && offsetof(CvtJob, tile0) == 48 && offsetof(CvtJob, dst_ld) == 56, "CvtJob layout is read word-wise from LDS");
constexpr int N_CVT = 16;
#ifndef DENSE_F8
#define DENSE_F8 0
#endif
#ifndef MOE_F8
#define MOE_F8 1
#endif
#ifndef MOED_F8
#define MOED_F8 1
#endif
constexpr int W2_F8 = 6; constexpr int KD8 = 1536;
static_assert(OFF_UE + (size_t)MOE_ROWS * (MOED_F8 ? (size_t)KD8 : (size_t)D_FFE * 2) <= OFF_XB && OFF_U + (size_t)TOK * D_FF * 2 <= OFF_XB, "FFN overlays must stay below the residual stream");
#ifndef DENSED_F8
#define DENSED_F8 1
#endif
#ifndef WIN1_F8
#define WIN1_F8 1
#endif
constexpr int W13_F8 = 5;
#ifndef OUT_F8
#define OUT_F8 1
#endif
constexpr int OUT_A_SH = 3;
#ifndef USE_I8
#define USE_I8 1
#endif
constexpr int N_I8J = 10;
__host__ __device__ constexpr int i8job(int i) { return i < 6 ? i : (i == 6 ? 9 : (i == 7 ? 10 : (i == 8 ? 12 : 13))); }
constexpr int I8_FLAG = 64;
constexpr float I8_CLIP = 4.0f;
constexpr size_t OFF_WSTEP = OFF_MISC + 9 * MiB;
constexpr size_t OFF_RSH = OFF_MISC + 9 * MiB + 4096;
constexpr size_t OFF_RSE = OFF_MISC + 10 * MiB;
struct CvtJobs { CvtJob j[N_CVT]; int total_tiles; int pad; };
typedef float vf4 __attribute__((ext_vector_type(4)));
constexpr int MT_PITCH = 132;
__device__ __forceinline__ void cvt_mt_load(const CvtJob& jb, int lt, int t, vf4 (&ld)[8]) {
    const int tk = jb.K / 64, tn = jb.ncols / 128, per_b = tk * tn, b = lt / per_b, r = lt % per_b, kt = r / tn, ntile = r % tn;
    const float* sp = jb.src + (size_t)b * jb.src_bstride + (size_t)(kt * 64) * jb.ldsrc + ntile * 128;
    const int r0 = t >> 5, c4 = (t & 31) * 4;
#pragma unroll
    for (int q = 0; q < 8; ++q) ld[q] = *(const vf4*)(sp + (size_t)(r0 + 8 * q) * jb.ldsrc + c4);
}
__device__ __forceinline__ void cvt_mt_lds(int t, const vf4 (&ld)[8], LAS3 float* tile) {
    const int r0 = t >> 5, c4 = (t & 31) * 4;
#pragma unroll
    for (int q = 0; q < 8; ++q) *(LAS3 vf4*)(tile + (r0 + 8 * q) * MT_PITCH + c4) = ld[q];
}
__device__ __forceinline__ void cvt_mt_store(const CvtJob& jb, int lt, int t, const LAS3 float* tile, const LAS3 float* wql) {
    const int tk = jb.K / 64, tn = jb.ncols / 128, per_b = tk * tn, b = lt / per_b, r = lt % per_b, kt = r / tn, ntile = r % tn;
    const int nl = t >> 1, kh = (t & 1) * 32, j = ntile * 128 + nl;
    const int drow = b * jb.dst_rows_per_batch + (jb.mode == 0 ? j : ((j >> 7) * 256 + (j & 127) + (jb.mode == 2 ? 128 : 0)));
    float v[32];
#pragma unroll
    for (int i = 0; i < 32; ++i) v[i] = tile[(kh + i) * MT_PITCH + nl];
    if (jb.f8 >= I8_FLAG) {
        const float qm = wql[jb.pad]; unsigned w[8];
#pragma unroll
        for (int i = 0; i < 8; ++i) w[i] = pack_i8x4(__builtin_amdgcn_fmed3f(v[4 * i] * qm, -127.0f, 127.0f), __builtin_amdgcn_fmed3f(v[4 * i + 1] * qm, -127.0f, 127.0f),
                                                      __builtin_amdgcn_fmed3f(v[4 * i + 2] * qm, -127.0f, 127.0f), __builtin_amdgcn_fmed3f(v[4 * i + 3] * qm, -127.0f, 127.0f));
        uint4* dp = (uint4*)((unsigned char*)jb.dst + (size_t)drow * jb.dst_ld + kt * 64 + kh);
        dp[0] = make_uint4(w[0], w[1], w[2], w[3]); dp[1] = make_uint4(w[4], w[5], w[6], w[7]);
        return; }
    if (jb.f8) {
        const float sc = (float)(1 << jb.f8); unsigned w[8];
#pragma unroll
        for (int i = 0; i < 8; ++i) { unsigned q = 0u;
            q = __builtin_amdgcn_cvt_pk_fp8_f32(sat8(v[4 * i] * sc), sat8(v[4 * i + 1] * sc), q, false);
            q = __builtin_amdgcn_cvt_pk_fp8_f32(sat8(v[4 * i + 2] * sc), sat8(v[4 * i + 3] * sc), q, true); w[i] = q; }
        uint4* dp = (uint4*)((unsigned char*)jb.dst + (size_t)drow * jb.dst_ld + kt * 64 + kh);
        dp[0] = make_uint4(w[0], w[1], w[2], w[3]); dp[1] = make_uint4(w[4], w[5], w[6], w[7]);
        return; }
    unsigned w[16];
#pragma unroll
    for (int i = 0; i < 16; ++i) w[i] = cvt2bf(v[2 * i], v[2 * i + 1]);
    uint4* dp = (uint4*)(jb.dst + (size_t)drow * jb.dst_ld + kt * 64 + kh);
#pragma unroll
    for (int i = 0; i < 4; ++i) dp[i] = make_uint4(w[4 * i], w[4 * i + 1], w[4 * i + 2], w[4 * i + 3]);
}
namespace sc {
typedef short bf16x8 __attribute__((ext_vector_type(8)));
typedef float f32x4 __attribute__((ext_vector_type(4)));
typedef unsigned u32x2 __attribute__((ext_vector_type(2)));
typedef unsigned u32x4v __attribute__((ext_vector_type(4)));
constexpr int PD = 136, PS = 72;
constexpr int SCAN_LDS = 128 * 1024;
DEVI f32x4 mma(bf16x8 x, bf16x8 y, f32x4 c) { return __builtin_amdgcn_mfma_f32_16x16x32_bf16(x, y, c, 0, 0, 0); }
DEVI bf16x8 ldf(const LAS3 bf16_t* base, int pitch, int row, int k0) { return *(const LAS3 bf16x8*)(base + row * pitch + k0); }
DEVI unsigned pk2(float lo, float hi) { return cvt2bf(lo, hi); }
DEVI void st4(LAS3 bf16_t* p, f32x4 v) { u32x2 w; w.x = pk2(v[0], v[1]); w.y = pk2(v[2], v[3]); *(LAS3 u32x2*)p = w; }
DEVI float clampe(float x) { return __builtin_amdgcn_fmed3f(x, -80.f, 80.f); }

DEVI void lds_barrier() { asm volatile("s_waitcnt lgkmcnt(0)" ::: "memory"); __builtin_amdgcn_s_barrier(); asm volatile("" ::: "memory"); }
#define SC_FENCE() __builtin_amdgcn_sched_barrier(0)
DEVI void hgrn2_item(LAS3 unsigned char* L, int b, int h, const bf16_t* QM, bf16_t* YO, const float* __restrict__ LF, const bf16_t* __restrict__ HI, const bf16_t* __restrict__ HG, const float* __restrict__ gnorm) {
    LAS3 bf16_t* Qt = (LAS3 bf16_t*)L;
    LAS3 bf16_t* Kt = Qt + 64 * PD;
    LAS3 bf16_t* KtT = Kt + 64 * PD;
    LAS3 bf16_t* VT = KtT + 128 * PS;
    LAS3 bf16_t* Pm = VT + 128 * PS;
    LAS3 bf16_t* ST = Pm + 64 * PS;
    LAS3 float* er = (LAS3 float*)(ST + 128 * PD);
    LAS3 float* ea = er + 128;
    LAS3 float* segs = ea + 128;
    LAS3 float* red = segs + 512;
    LAS3 float* gnl = red + 128;
    const int tid = tid_(), wid = __builtin_amdgcn_readfirstlane(tid >> 6), lane = tid & 63, fr = lane & 15, fq = lane >> 4;
    const int ch = tid & 127, sg = tid >> 7;
    const int tj = wid & 3, hw = wid >> 2;
    f32x4 S[8];
#pragma unroll
    for (int i = 0; i < 8; ++i) S[i] = (f32x4){0.f, 0.f, 0.f, 0.f};
    if (tid < 128) gnl[tid] = gnorm[h * 128 + tid];
    float lfv[16]; bf16_t qv[16], vv[16];
#define HG_LOAD(cc) do { const size_t r0_ = (size_t)b * SEQL + (size_t)(cc) * 64; \
        const float* lp = LF + (r0_ + 16 * sg) * 512 + h * 128 + ch; const bf16_t* qp = QM + (r0_ + 16 * sg) * 1024 + h * 128 + ch; const bf16_t* vp = HI + (r0_ + 16 * sg) * 512 + h * 128 + ch; \
        _Pragma("unroll") for (int i = 0; i < 16; ++i) { lfv[i] = lp[(size_t)i * 512]; qv[i] = qp[(size_t)i * 1024]; vv[i] = vp[(size_t)i * 512]; } } while (0)
    HG_LOAD(0);
    for (int c = 0; c < SEQL / 64; ++c) {
        const size_t row0 = (size_t)b * SEQL + (size_t)c * 64;
        float a[16]; uint2 hgv[4];
        { float run = 0.f;
#pragma unroll
          for (int i = 0; i < 16; ++i) { run += lfv[i]; a[i] = run; }
          segs[sg * 128 + ch] = run; }
#pragma unroll
        for (int q = 0; q < 4; ++q) hgv[q] = *(const uint2*)(HG + (row0 + 16 * tj + fr) * 512 + h * 128 + 16 * (4 * hw + q) + 4 * fq);
        lds_barrier();
        { const float s0 = segs[ch], s1 = segs[128 + ch], s2 = segs[256 + ch], s3 = segs[384 + ch];
          const float off = (sg > 0 ? s0 : 0.f) + (sg > 1 ? s1 : 0.f) + (sg > 2 ? s2 : 0.f), r = s0 + s1, alast = (s0 + s1) + (s2 + s3);
          if (sg == 0) { er[ch] = __expf(fmaxf(r, -80.f)); ea[ch] = __expf(fmaxf(alast - r, -80.f)); }
          unsigned kw[8], vw[8];
#pragma unroll
          for (int i = 0; i < 16; i += 2) {
              const float A0 = off + a[i], A1 = off + a[i + 1];
              const float e0 = __expf(clampe(A0 - r)), e1 = __expf(clampe(A1 - r));
              const float q0 = bf2f(qv[i]) * e0, q1 = bf2f(qv[i + 1]) * e1;
              const float kk0 = 1.0f - __expf(lfv[i]), kk1 = 1.0f - __expf(lfv[i + 1]);
              const float k0 = kk0 * __builtin_amdgcn_rcpf(e0), k1 = kk1 * __builtin_amdgcn_rcpf(e1);
              const unsigned kp = pk2(k0, k1);
              Qt[(16 * sg + i) * PD + ch] = f2bf(q0); Qt[(16 * sg + i + 1) * PD + ch] = f2bf(q1);
              Kt[(16 * sg + i) * PD + ch] = (bf16_t)(kp & 0xffffu); Kt[(16 * sg + i + 1) * PD + ch] = (bf16_t)(kp >> 16);
              kw[i >> 1] = kp; vw[i >> 1] = (unsigned)vv[i] | ((unsigned)vv[i + 1] << 16);
          }
          *(LAS3 u32x4v*)(KtT + ch * PS + 16 * sg) = (u32x4v){kw[0], kw[1], kw[2], kw[3]}; *(LAS3 u32x4v*)(KtT + ch * PS + 16 * sg + 8) = (u32x4v){kw[4], kw[5], kw[6], kw[7]};
          *(LAS3 u32x4v*)(VT + ch * PS + 16 * sg) = (u32x4v){vw[0], vw[1], vw[2], vw[3]}; *(LAS3 u32x4v*)(VT + ch * PS + 16 * sg + 8) = (u32x4v){vw[4], vw[5], vw[6], vw[7]}; }
        if (c + 1 < SEQL / 64) HG_LOAD(c + 1);
        lds_barrier();
        { const f32x4 erv = *(const LAS3 f32x4*)(er + 16 * wid + 4 * fq);
#pragma unroll
          for (int vt = 0; vt < 8; ++vt) { S[vt] *= erv; st4(ST + (16 * vt + fr) * PD + 16 * wid + 4 * fq, S[vt]); } }
        { const int ti = wid >> 1; bf16x8 yq1[4], xk1[2][4];
#pragma unroll
          for (int k4 = 0; k4 < 4; ++k4) yq1[k4] = ldf(Qt, PD, 16 * ti + fr, 32 * k4 + 8 * fq);
#pragma unroll
          for (int q2 = 0; q2 < 2; ++q2)
#pragma unroll
              for (int k4 = 0; k4 < 4; ++k4) xk1[q2][k4] = ldf(Kt, PD, 16 * (2 * (wid & 1) + q2) + fr, 32 * k4 + 8 * fq);
          SC_FENCE();
#pragma unroll
          for (int q2 = 0; q2 < 2; ++q2) { const int si = 2 * (wid & 1) + q2; f32x4 acc = (f32x4){0.f, 0.f, 0.f, 0.f};
#pragma unroll
              for (int k4 = 0; k4 < 4; ++k4) acc = mma(xk1[q2][k4], yq1[k4], acc);
              const int t = 16 * ti + fr, s0 = 16 * si + 4 * fq;
#pragma unroll
              for (int j = 0; j < 4; ++j) acc[j] = (s0 + j <= t) ? acc[j] : 0.f;
              st4(Pm + t * PS + s0, acc); } }
        lds_barrier();
        f32x4 O[4];
        { bf16x8 yp[2], yq[4], xv[2][6];
#pragma unroll
          for (int k2 = 0; k2 < 2; ++k2) yp[k2] = ldf(Pm, PS, 16 * tj + fr, 32 * k2 + 8 * fq);
#pragma unroll
          for (int k4 = 0; k4 < 4; ++k4) yq[k4] = ldf(Qt, PD, 16 * tj + fr, 32 * k4 + 8 * fq);
#define HG_LDX(buf, q_) do { const int vi_ = 4 * hw + (q_); _Pragma("unroll") for (int k2 = 0; k2 < 2; ++k2) xv[buf][k2] = ldf(VT, PS, 16 * vi_ + fr, 32 * k2 + 8 * fq); \
              _Pragma("unroll") for (int k4 = 0; k4 < 4; ++k4) xv[buf][2 + k4] = ldf(ST, PD, 16 * vi_ + fr, 32 * k4 + 8 * fq); } while (0)
          HG_LDX(0, 0);
#pragma unroll
          for (int q = 0; q < 4; ++q) { if (q + 1 < 4) HG_LDX((q + 1) & 1, q + 1);
              SC_FENCE();
              f32x4 acc = (f32x4){0.f, 0.f, 0.f, 0.f};
#pragma unroll
              for (int k2 = 0; k2 < 2; ++k2) acc = mma(xv[q & 1][k2], yp[k2], acc);
#pragma unroll
              for (int k4 = 0; k4 < 4; ++k4) acc = mma(xv[q & 1][2 + k4], yq[k4], acc);
              O[q] = acc; SC_FENCE(); }
#undef HG_LDX
        }
        { float ss = 0.f;
#pragma unroll
          for (int q = 0; q < 4; ++q) ss += O[q][0] * O[q][0] + O[q][1] * O[q][1] + O[q][2] * O[q][2] + O[q][3] * O[q][3];
          ss += __shfl_xor(ss, 16); ss += __shfl_xor(ss, 32);
          if (fq == 0) red[hw * 64 + 16 * tj + fr] = ss; }
        { bf16x8 xk[2], yv[2][8];
#pragma unroll
          for (int k2 = 0; k2 < 2; ++k2) xk[k2] = ldf(KtT, PS, 16 * wid + fr, 32 * k2 + 8 * fq);
          const f32x4 eav = *(const LAS3 f32x4*)(ea + 16 * wid + 4 * fq);
#define HG_LDV(buf, v0_) do { _Pragma("unroll") for (int i = 0; i < 4; ++i) _Pragma("unroll") for (int k2 = 0; k2 < 2; ++k2) yv[buf][2 * i + k2] = ldf(VT, PS, 16 * ((v0_) + i) + fr, 32 * k2 + 8 * fq); } while (0)
          HG_LDV(0, 0);
#pragma unroll
          for (int hf = 0; hf < 2; ++hf) { if (hf == 0) HG_LDV(1, 4);
              SC_FENCE();
#pragma unroll
              for (int i = 0; i < 4; ++i) { const int vt = 4 * hf + i;
#pragma unroll
                  for (int k2 = 0; k2 < 2; ++k2) S[vt] = mma(xk[k2], yv[hf][2 * i + k2], S[vt]);
                  S[vt] *= eav; }
              SC_FENCE(); }
#undef HG_LDV
        }
        lds_barrier();
        f32x4 gnr[4];
#pragma unroll
        for (int q = 0; q < 4; ++q) gnr[q] = *(const LAS3 f32x4*)(gnl + 16 * (4 * hw + q) + 4 * fq);
        { const float tot = red[16 * tj + fr] + red[64 + 16 * tj + fr]; const float rstd = rsqrtf(tot * (1.0f / 128.0f) + EPS);
          bf16_t* yp = YO + (row0 + 16 * tj + fr) * 1024 + h * 128 + 4 * fq;
#pragma unroll
          for (int q = 0; q < 4; ++q) { f32x4 g;
              g[0] = __uint_as_float(hgv[q].x << 16); g[1] = __uint_as_float(hgv[q].x & 0xffff0000u); g[2] = __uint_as_float(hgv[q].y << 16); g[3] = __uint_as_float(hgv[q].y & 0xffff0000u);
              const f32x4 y = O[q] * rstd * gnr[q] * g; uint2 w; w.x = pk2(y[0], y[1]); w.y = pk2(y[2], y[3]);
              *(uint2*)(yp + 16 * (4 * hw + q)) = w; } }
    }
}
#undef HG_LOAD

DEVI void mlstm_item(LAS3 unsigned char* L, int b, int h, const bf16_t* QM, bf16_t* YO, const bf16_t* __restrict__ MU, const bf16_t* __restrict__ MV, const float* __restrict__ GATES,
                     const float* __restrict__ cw, const float* __restrict__ cb, const float* __restrict__ wq, const float* __restrict__ wk, float fb, const float* __restrict__ gnorm, unsigned* dbg) {
    (void)dbg;
    LAS3 bf16_t* UCt = (LAS3 bf16_t*)L;
    LAS3 bf16_t* WqT = UCt + 64 * PD;
    LAS3 bf16_t* WkT = WqT + 64 * PD;
    LAS3 bf16_t* Qm = WkT + 64 * PD;
    LAS3 bf16_t* Km = Qm + 64 * PS;
    LAS3 bf16_t* KwT = Km + 64 * PS;
    LAS3 bf16_t* VT = KwT + 64 * PS;
    LAS3 bf16_t* CT = VT + 144 * PS;
    LAS3 float* gvec = (LAS3 float*)(CT + 144 * PS);
    LAS3 float* Mvec = gvec + 64;
    LAS3 float* wint = Mvec + 64;
    LAS3 float* wsv = wint + 64;
    LAS3 float* emt = wsv + 64;
    LAS3 float* red = emt + 64;
    LAS3 float* scal = red + 128;
    LAS3 float* gnl = scal + 4;
    LAS3 bf16_t* Pm = UCt;
    const int tid = tid_(), wid = __builtin_amdgcn_readfirstlane(tid >> 6), lane = tid & 63, fr = lane & 15, fq = lane >> 4;
    const int ch = tid & 127, sg = tid >> 7;
    const int tj = wid & 3, hw = wid >> 2;
    for (int i = tid; i < 128 * 64; i += 512) { const int d = i >> 6, e = i & 63; WqT[e * PD + d] = f2bf(0.125f * wq[i]); WkT[e * PD + d] = f2bf(wk[i]); }
    for (int i = tid; i < 144 * PS; i += 512) { CT[i] = 0; if (i >= 128 * PS) VT[i] = (i < 129 * PS) ? (bf16_t)0x3F80 : (bf16_t)0; }
    f32x4 Cst[5];
#pragma unroll
    for (int i = 0; i < 5; ++i) Cst[i] = (f32x4){0.f, 0.f, 0.f, 0.f};
    const float cw0 = cw[ch + h * 128], cw1 = cw[512 + ch + h * 128], cw2 = cw[1024 + ch + h * 128], cw3 = cw[1536 + ch + h * 128], cbv = cb[ch + h * 128];
    float m_prev = 0.f;
    if (tid < 128) gnl[tid] = gnorm[h * 128 + tid];
    __syncthreads();
    bf16_t mur[19], vv[16]; float gin = 0.f, gfn = 0.f;
#define ML_LOAD(cc) do { const size_t r0_ = (size_t)b * SEQL + (size_t)(cc) * 64; \
        const bf16_t* mp = MU + (r0_ + 16 * sg) * 512 + h * 128 + ch; const bf16_t* vp = MV + (r0_ + 16 * sg) * 512 + h * 128 + ch; \
        _Pragma("unroll") for (int i = 0; i < 19; ++i) { const int tl = 64 * (cc) + 16 * sg + i - 3; mur[i] = (tl >= 0) ? mp[((long)i - 3) * 512] : (bf16_t)0; } \
        _Pragma("unroll") for (int i = 0; i < 16; ++i) vv[i] = vp[(size_t)i * 512]; \
        if (wid == 0) { gin = GATES[(r0_ + lane) * 8 + h]; gfn = GATES[(r0_ + lane) * 8 + 4 + h]; } } while (0)
    ML_LOAD(0);
    for (int c = 0; c < SEQL / 64; ++c) {
        const size_t row0 = (size_t)b * SEQL + (size_t)c * 64;
        { float mu[19];
#pragma unroll
          for (int i = 0; i < 19; ++i) mu[i] = bf2f(mur[i]);
#pragma unroll
          for (int i = 0; i < 16; ++i) { const float y = cbv + cw0 * mu[i] + cw1 * mu[i + 1] + cw2 * mu[i + 2] + cw3 * mu[i + 3]; UCt[(16 * sg + i) * PD + ch] = f2bf(y * __builtin_amdgcn_rcpf(1.0f + __expf(-y))); }
          unsigned vw[8];
#pragma unroll
          for (int i = 0; i < 8; ++i) vw[i] = (unsigned)vv[2 * i] | ((unsigned)vv[2 * i + 1] << 16);
          *(LAS3 u32x4v*)(VT + ch * PS + 16 * sg) = (u32x4v){vw[0], vw[1], vw[2], vw[3]}; *(LAS3 u32x4v*)(VT + ch * PS + 16 * sg + 8) = (u32x4v){vw[4], vw[5], vw[6], vw[7]}; }
        uint2 mov[4];
#pragma unroll
        for (int q = 0; q < 4; ++q) mov[q] = *(const uint2*)(QM + (row0 + 16 * tj + fr) * 1024 + 512 + h * 128 + 16 * (4 * hw + q) + 4 * fq);
        const float gmi = gin, gmf = gfn;
        if (c + 1 < SEQL / 64) ML_LOAD(c + 1);
        if (wid == 0) {
            const float mi = gmi, z = gmf + fb;
            const float lf = fminf(z, 0.f) - log1pf(__expf(-fabsf(z)));
            const float bsum = wave_scan_sum(lf);
            const float g = mi - bsum; const float cm = wave_scan_max(g);
            const float M = fmaxf(m_prev, cm);
            const float M63 = lane63(M), b63 = lane63(bsum);
            gvec[lane] = g; Mvec[lane] = M; wint[lane] = __expf(m_prev - M); wsv[lane] = __expf(g - M63); emt[lane] = __expf(-(bsum + M));
            if (lane == 0) scal[0] = __expf(m_prev - M63);
            m_prev = b63 + M63;
        }
        lds_barrier();
        { bf16x8 yu[4], xw[2][8];
#pragma unroll
          for (int k4 = 0; k4 < 4; ++k4) yu[k4] = ldf(UCt, PD, 16 * tj + fr, 32 * k4 + 8 * fq);
#define ML_LDW(buf, q2_) do { const int ei_ = 2 * hw + (q2_); _Pragma("unroll") for (int k4 = 0; k4 < 4; ++k4) { xw[buf][k4] = ldf(WqT, PD, 16 * ei_ + fr, 32 * k4 + 8 * fq); xw[buf][4 + k4] = ldf(WkT, PD, 16 * ei_ + fr, 32 * k4 + 8 * fq); } } while (0)
          ML_LDW(0, 0);
#pragma unroll
          for (int q2 = 0; q2 < 2; ++q2) { const int ei = 2 * hw + q2; f32x4 aq = (f32x4){0.f, 0.f, 0.f, 0.f}, ak = aq, akt = aq;
              if (q2 == 0) ML_LDW(1, 1);
              SC_FENCE();
#pragma unroll
              for (int k4 = 0; k4 < 4; ++k4) { aq = mma(xw[q2][k4], yu[k4], aq); ak = mma(xw[q2][4 + k4], yu[k4], ak); akt = mma(yu[k4], xw[q2][4 + k4], akt); }
              SC_FENCE();
              st4(Qm + (16 * tj + fr) * PS + 16 * ei + 4 * fq, aq); st4(Km + (16 * tj + fr) * PS + 16 * ei + 4 * fq, ak);
              const f32x4 wv = *(const LAS3 f32x4*)(wsv + 16 * tj + 4 * fq);
              st4(KwT + (16 * ei + fr) * PS + 16 * tj + 4 * fq, akt * wv); }
#undef ML_LDW
        }
        lds_barrier();
        { const int ti = wid >> 1; const float Mt = Mvec[16 * ti + fr]; bf16x8 yq2[2], xk2[2][2];
#pragma unroll
          for (int k2 = 0; k2 < 2; ++k2) yq2[k2] = ldf(Qm, PS, 16 * ti + fr, 32 * k2 + 8 * fq);
#pragma unroll
          for (int q2 = 0; q2 < 2; ++q2)
#pragma unroll
              for (int k2 = 0; k2 < 2; ++k2) xk2[q2][k2] = ldf(Km, PS, 16 * (2 * (wid & 1) + q2) + fr, 32 * k2 + 8 * fq);
          SC_FENCE();
#pragma unroll
          for (int q2 = 0; q2 < 2; ++q2) { const int si = 2 * (wid & 1) + q2; f32x4 acc = (f32x4){0.f, 0.f, 0.f, 0.f};
#pragma unroll
              for (int k2 = 0; k2 < 2; ++k2) acc = mma(xk2[q2][k2], yq2[k2], acc);
              const int t = 16 * ti + fr, s0 = 16 * si + 4 * fq; const f32x4 gv = *(const LAS3 f32x4*)(gvec + s0);
#pragma unroll
              for (int j = 0; j < 4; ++j) acc[j] = (s0 + j <= t) ? acc[j] * __expf(gv[j] - Mt) : 0.f;
              st4(Pm + t * PS + s0, acc); } }
        lds_barrier();
        f32x4 O[4]; float den;
        { bf16x8 yq[2], yp[2], xk[2], vt[5][2], ct[2][2];
#pragma unroll
          for (int k2 = 0; k2 < 2; ++k2) { yq[k2] = ldf(Qm, PS, 16 * tj + fr, 32 * k2 + 8 * fq); yp[k2] = ldf(Pm, PS, 16 * tj + fr, 32 * k2 + 8 * fq); }
#define ML_VI(q_) (((q_) < 4) ? 4 * hw + (q_) : 8)
#pragma unroll
          for (int k2 = 0; k2 < 2; ++k2) ct[0][k2] = ldf(CT, PS, 16 * ML_VI(0) + fr, 32 * k2 + 8 * fq);
#pragma unroll
          for (int q = 0; q < 5; ++q)
#pragma unroll
              for (int k2 = 0; k2 < 2; ++k2) vt[q][k2] = ldf(VT, PS, 16 * ML_VI(q) + fr, 32 * k2 + 8 * fq);
#pragma unroll
          for (int k2 = 0; k2 < 2; ++k2) xk[k2] = ldf(KwT, PS, 16 * tj + fr, 32 * k2 + 8 * fq);
          const float wi = wint[16 * tj + fr];
          const float dp = scal[0];
#pragma unroll
          for (int q = 0; q < 5; ++q) { f32x4 acc = (f32x4){0.f, 0.f, 0.f, 0.f};
              if (q < 4) {
#pragma unroll
                  for (int k2 = 0; k2 < 2; ++k2) ct[(q + 1) & 1][k2] = ldf(CT, PS, 16 * ML_VI(q + 1) + fr, 32 * k2 + 8 * fq); }
              SC_FENCE();
#pragma unroll
              for (int k2 = 0; k2 < 2; ++k2) acc = mma(ct[q & 1][k2], yq[k2], acc);
              acc *= wi;
#pragma unroll
              for (int k2 = 0; k2 < 2; ++k2) acc = mma(vt[q][k2], yp[k2], acc);
              SC_FENCE();
              if (q < 4) O[q] = acc; else den = __shfl(acc[0], fr); }
          const float dn = __builtin_amdgcn_rcpf(fmaxf(fabsf(den), emt[16 * tj + fr])); float ss = 0.f;
#pragma unroll
          for (int q = 0; q < 4; ++q) { O[q] *= dn; ss += O[q][0] * O[q][0] + O[q][1] * O[q][1] + O[q][2] * O[q][2] + O[q][3] * O[q][3]; }
          ss += __shfl_xor(ss, 16); ss += __shfl_xor(ss, 32);
          if (fq == 0) red[hw * 64 + 16 * tj + fr] = ss;
#pragma unroll
          for (int q = 0; q < 5; ++q) { if (q == 4 && hw != 0) break; Cst[q] *= dp;
#pragma unroll
              for (int k2 = 0; k2 < 2; ++k2) Cst[q] = mma(xk[k2], vt[q][k2], Cst[q]); }
#undef ML_VI
        }
        lds_barrier();
        f32x4 gnr[4];
#pragma unroll
        for (int q = 0; q < 4; ++q) gnr[q] = *(const LAS3 f32x4*)(gnl + 16 * (4 * hw + q) + 4 * fq);
        { const float tot = red[16 * tj + fr] + red[64 + 16 * tj + fr]; const float rstd = rsqrtf(tot * (1.0f / 128.0f) + EPS);
          bf16_t* yp = YO + (row0 + 16 * tj + fr) * 1024 + 512 + h * 128 + 4 * fq;
#pragma unroll
          for (int q = 0; q < 4; ++q) { f32x4 g;
              g[0] = __uint_as_float(mov[q].x << 16); g[1] = __uint_as_float(mov[q].x & 0xffff0000u); g[2] = __uint_as_float(mov[q].y << 16); g[3] = __uint_as_float(mov[q].y & 0xffff0000u);
              const f32x4 y = O[q] * rstd * gnr[q] * g; uint2 w; w.x = pk2(y[0], y[1]); w.y = pk2(y[2], y[3]);
              *(uint2*)(yp + 16 * (4 * hw + q)) = w; }
#pragma unroll
          for (int q = 0; q < 5; ++q) { if (q == 4 && hw != 0) break; const int vi = (q < 4) ? 4 * hw + q : 8; st4(CT + (16 * vi + fr) * PS + 16 * tj + 4 * fq, Cst[q]); } }
    }
}
#undef ML_LOAD
struct ScanArgs { const bf16_t* QM; bf16_t* YO; const float* LF; const bf16_t* HI; const bf16_t* HG; const bf16_t* MU; const bf16_t* MV; const float* GATES;
                  const float* hg_norm_g; const float* ml_norm_g; const float* conv_w; const float* conv_b; const float* wq; const float* wk; const float* fbias; unsigned* dbg; };
DEVI void scan_item(LAS3 unsigned char* L, const ScanArgs& a, int item) {
    const int bh = item & 127, b = bh >> 2, h = bh & 3;
    if (item < 128) hgrn2_item(L, b, h, a.QM, a.YO, a.LF, a.HI, a.HG, a.hg_norm_g);
    else mlstm_item(L, b, h, a.QM, a.YO, a.MU, a.MV, a.GATES, a.conv_w, a.conv_b, a.wq + (size_t)h * 128 * 64, a.wk + (size_t)h * 128 * 64, a.fbias[h], a.ml_norm_g, a.dbg);
}
}
constexpr size_t WT_IN = 0;
constexpr size_t WT_BRH = WT_IN + 2ull * 5632 * 1024;
constexpr size_t WT_BRM = WT_BRH + 2ull * 1024 * 512;
constexpr size_t WT_OUT = WT_BRM + 2ull * 1024 * 512;
constexpr size_t WT_F13 = WT_OUT + 2ull * 1024 * 1024;
constexpr size_t WT_F2 = WT_F13 + 5632ull * 1024;
constexpr size_t WT_M13 = WT_F2 + 1024ull * 2816;
constexpr size_t WT_M2 = WT_M13 + 8ull * 2816 * 1024;
constexpr size_t WT_END = WT_M2 + 8ull * 1024 * 1408;
static_assert(WT_END * 2 <= 120 * MiB, "weights region");


#define XB_TMO      128
#define XB_XCNT(j)  (256  + 64 * (j))
#define XB_XSUB(j)  (1280 + 64 * (j))
#define XB_XGEN(j)  (2304 + 64 * (j))
#define XB_TOP      3328
#define XB_TOPGEN   3392
#define XCD_BAR_WORDS 3456
#define XB_SPIN_CAP (1u << 18)
#define LAS __attribute__((address_space(3)))
__device__ __forceinline__ unsigned xb_ld(unsigned* p)              { return __hip_atomic_load(p, __ATOMIC_RELAXED, __HIP_MEMORY_SCOPE_AGENT); }
__device__ __forceinline__ unsigned xb_add(unsigned* p, unsigned v) { return __hip_atomic_fetch_add(p, v, __ATOMIC_RELAXED, __HIP_MEMORY_SCOPE_AGENT); }
__device__ __forceinline__ unsigned xb_xcc_id() { return (unsigned)__builtin_amdgcn_s_getreg((3 << 11) | 20) & 0xFu; }
#define XB_SPIN(cond, bar) do { unsigned _sp = 0; while (cond) { __builtin_amdgcn_s_sleep(1); \
    if ((++_sp & 255u) == 0u) { if (xb_ld(&(bar)[XB_TMO])) break; if (_sp > XB_SPIN_CAP) { atomicAdd(&(bar)[XB_TMO], 1u); break; } } } } while (0)
struct XcdBarrier { unsigned* bar; unsigned x; volatile LAS unsigned* st; };
__device__ __forceinline__ XcdBarrier xcd_barrier_post(unsigned* bar, volatile LAS unsigned* st) {
    XcdBarrier b; b.bar = bar; b.x = xb_xcc_id(); b.st = st;
    if (tid_() == 0) (void)xb_add(&bar[XB_XCNT(b.x)], 1u);
    return b;
}
__device__ __forceinline__ void xcd_barrier_complete(unsigned* bar, unsigned x, unsigned& nloc, unsigned& nx) {
    const unsigned G = gridDim.x * gridDim.y * gridDim.z;
    unsigned sum, cnt, mine, sp = 0u;
    for (;;) {
        sum = 0u; cnt = 0u; mine = 0u;
#pragma unroll
        for (unsigned j = 0; j < 16; ++j) { const unsigned c = xb_ld(&bar[XB_XCNT(j)]); sum += c; cnt += (c > 0u) ? 1u : 0u; mine = (j == x) ? c : mine; }
        if (sum == G) break;
        __builtin_amdgcn_s_sleep(1);
        if ((++sp & 255u) == 0u) { if (xb_ld(&bar[XB_TMO])) break; if (sp > XB_SPIN_CAP) { atomicAdd(&bar[XB_TMO], 1u); break; } }
    }
    nloc = mine > 0u ? mine : 1u; nx = cnt > 0u ? cnt : 1u;
}
__device__ __forceinline__ void xcd_barrier(const XcdBarrier& b) {
    asm volatile("s_waitcnt vmcnt(0)" ::: "memory");
    __syncthreads();
    if (tid_() == 0) {
        unsigned* bar = b.bar;
        __builtin_amdgcn_s_waitcnt(0);
        unsigned nloc = b.st[0], nx = b.st[1];
        if (nloc == 0u) { xcd_barrier_complete(bar, b.x, nloc, nx); b.st[0] = nloc; b.st[1] = nx; }
        const unsigned old = xb_add(&bar[XB_XSUB(b.x)], 1u);
        const unsigned gen = old / nloc;
        if (old + 1u == (gen + 1u) * nloc) {
            __builtin_amdgcn_fence(__ATOMIC_RELEASE, "agent");
            asm volatile("s_waitcnt vmcnt(0)" ::: "memory");
            const unsigned og = xb_add(&bar[XB_TOP], 1u);
            const unsigned tg = og / nx;
            if (og + 1u == (tg + 1u) * nx) xb_add(&bar[XB_TOPGEN], 1u);
            else XB_SPIN(xb_ld(&bar[XB_TOPGEN]) == tg, bar);
            __builtin_amdgcn_fence(__ATOMIC_ACQUIRE, "agent");
            xb_add(&bar[XB_XGEN(b.x)], 1u);
            asm volatile("s_waitcnt vmcnt(0)" ::: "memory");
        } else {
            XB_SPIN(xb_ld(&bar[XB_XGEN(b.x)]) == gen, bar);
            __builtin_amdgcn_fence(__ATOMIC_ACQUIRE, "agent");
            asm volatile("s_waitcnt vmcnt(0)" ::: "memory");
        }
    }
    __syncthreads();
}

enum { I_X = 0, I_C, I_NORM_MIX_G, I_ADA_MIX_W, I_ADA_MIX_B, I_W_IN, I_LB, I_HG_NORM, I_CONV_W, I_CONV_B, I_WQ, I_WK, I_FBIAS, I_ML_NORM, I_BRH, I_BRM, I_WOUT,
       I_NORM_FFN_G, I_ADA_FFN_W, I_ADA_FFN_B, I_FW1, I_FW3, I_FW2, I_RW, I_RB, I_MW1, I_MW3, I_MW2, I_FINAL_G, N_IN };
struct Params { const float* in[N_IN]; float* out; unsigned char* ws; CvtJobs J; };
constexpr size_t OFF_BAR = OFF_MISC + 16 * 1024;
constexpr size_t OFF_CTR = OFF_MISC + 12 * 1024;
constexpr size_t OFF_MOECNT = OFF_CTR + 1024;
constexpr size_t OFF_LBT = OFF_MISC + 4096;
constexpr int LDS_BYTES = 128 * 1024 + 1024;
constexpr int LDSCTL = 128 * 1024;

DEVI void ada_unit(const Params& p, int unit, LAS3 unsigned char* lds, float* __restrict__ mod) {
    const int tid = tid_(), lane = tid & 63, kg = tid >> 6;
    const int s = unit / 48, jc = unit % 48, l = s >> 1, sub = s & 1;
    const float* W = (sub ? p.in[I_ADA_FFN_W] : p.in[I_ADA_MIX_W]) + (size_t)l * 1024 * 3072;
    const float* Bv = (sub ? p.in[I_ADA_FFN_B] : p.in[I_ADA_MIX_B]) + (size_t)l * 3072;
    const float* c = p.in[I_C];
    const int j = jc * 64 + lane;
    LAS3 float* ca = (LAS3 float*)lds;
    float acc[32];
#pragma unroll
    for (int b = 0; b < 32; ++b) acc[b] = 0.f;
    for (int k0 = 0; k0 < 1024; k0 += 256) {
#pragma unroll
        for (int i = 0; i < 16; ++i) { const int idx = tid + i * 512, bb = idx & 31, kk = idx >> 5; ca[kk * 32 + bb] = siluf_(c[bb * 1024 + k0 + kk]); }
        __syncthreads();
        for (int kk = 0; kk < 32; ++kk) { const int kl = kg * 32 + kk; const float wv = W[(size_t)(k0 + kl) * 3072 + j];
#pragma unroll
            for (int b4 = 0; b4 < 8; ++b4) { const sc::f32x4 cv = *(const LAS3 sc::f32x4*)(ca + kl * 32 + 4 * b4);
                acc[4 * b4] += cv[0] * wv; acc[4 * b4 + 1] += cv[1] * wv; acc[4 * b4 + 2] += cv[2] * wv; acc[4 * b4 + 3] += cv[3] * wv; } }
        __syncthreads();
    }
    LAS3 float* red = (LAS3 float*)lds;
#pragma unroll
    for (int b = 0; b < 32; ++b) red[(kg * 32 + b) * 64 + lane] = acc[b];
    __syncthreads();
#pragma unroll
    for (int i = 0; i < 4; ++i) { const int o = tid + i * 512, b = o >> 6, cl = o & 63; float sum = 0.f;
#pragma unroll
        for (int g = 0; g < 8; ++g) sum += red[(g * 32 + b) * 64 + cl];
        mod[((size_t)s * 32 + b) * 3072 + jc * 64 + cl] = sum + Bv[jc * 64 + cl]; }
    __syncthreads();
}
constexpr int CVT_LDS = 96 * 1024;
DEVI CvtJob cvt_lookup(const LAS3 unsigned* tb, int gt) {
    int ji = 0;
#pragma unroll
    for (int q = 1; q < N_CVT; ++q) ji = (gt >= (int)tb[q * (int)(sizeof(CvtJob) / 4) + (int)(offsetof(CvtJob, tile0) / 4)]) ? q : ji;
    const LAS3 unsigned* r = tb + ji * (int)(sizeof(CvtJob) / 4);
    CvtJob jb;
    jb.src = (const float*)(((unsigned long long)r[1] << 32) | r[0]); jb.dst = (bf16_t*)(((unsigned long long)r[3] << 32) | r[2]); jb.src_bstride = (long long)(((unsigned long long)r[5] << 32) | r[4]);
    jb.K = (int)r[6]; jb.ncols = (int)r[7]; jb.ldsrc = (int)r[8]; jb.nb = (int)r[9]; jb.dst_rows_per_batch = (int)r[10]; jb.mode = (int)r[11]; jb.tile0 = (int)r[12]; jb.f8 = (int)r[13]; jb.dst_ld = (int)r[14]; jb.pad = ji;
    return jb;
}
DEVI void ph_prologue(const Params& p, LAS3 unsigned char* lds) {
    const int tid = tid_(), half = tid >> 8, t = tid & 255;
    unsigned char* ws = p.ws;
    for (int u = (int)blockIdx.x; u < 192; u += (int)gridDim.x) ada_unit(p, u, lds, (float*)(ws + OFF_MOD));
    if (blockIdx.x == gridDim.x - 1) { const float* lg = p.in[I_LB]; float* lb = (float*)(ws + OFF_LBT); const float z0 = lg[tid], z1 = lg[512 + tid]; lb[tid] = 0.f; lb[512 + tid] = 1.0f / (1.0f + __expf(z0 - z1)); }
    if (MOED_F8) { unsigned char* w2 = (unsigned char*)((bf16_t*)(ws + OFF_WEIGHTS) + WT_M2);
        for (int i = (int)blockIdx.x * 512 + tid; i < 8192 * 8; i += (int)gridDim.x * 512) *(uint4*)(w2 + (size_t)(i >> 3) * KD8 + D_FFE + (i & 7) * 16) = make_uint4(0u, 0u, 0u, 0u); }
    LAS3 float* tile = (LAS3 float*)(lds + half * (64 * MT_PITCH * 4));
    LAS3 unsigned* tb = (LAS3 unsigned*)(lds + CVT_LDS);
    { const unsigned* ka = (const unsigned*)__builtin_amdgcn_kernarg_segment_ptr() + offsetof(Params, J) / 4;
      for (int i = tid; i < (int)(sizeof(CvtJobs) / 4); i += 512) tb[i] = ka[i];
      __syncthreads(); }
    LAS3 float* wql = (LAS3 float*)(lds + CVT_LDS + 2048);
    if (USE_I8) {
        LAS3 float* wpart = wql + N_CVT;
        float ssj[N_I8J];
#pragma unroll
        for (int i = 0; i < N_I8J; ++i) { const LAS3 unsigned* r = tb + i8job(i) * (int)(sizeof(CvtJob) / 4);
            const float* sp = (const float*)(((unsigned long long)r[1] << 32) | r[0]); const int ldsrc = (int)r[8]; float a = 0.f;
#pragma unroll
            for (int q = 0; q < 4; ++q) { const vf4 x = *(const vf4*)(sp + (size_t)((tid >> 5) + 16 * q) * ldsrc + (tid & 31) * 4); a += x[0] * x[0] + x[1] * x[1] + x[2] * x[2] + x[3] * x[3]; }
            ssj[i] = a; }
#pragma unroll
        for (int i = 0; i < N_I8J; ++i) { const float a = wave_sum(ssj[i]); if ((tid & 63) == 0) wpart[i * 8 + (tid >> 6)] = a; }
        __syncthreads();
        if (tid < N_I8J) { float tot = 0.f;
#pragma unroll
            for (int w = 0; w < 8; ++w) tot += wpart[tid * 8 + w];
            const float clip = fmaxf(I8_CLIP * sqrtf(tot * (1.0f / 8192.0f)), 1e-30f);
            wql[i8job(tid)] = 127.0f / clip;
            if (blockIdx.x == 0) ((float*)(ws + OFF_WSTEP))[i8job(tid)] = clip * (1.0f / 127.0f); }
        __syncthreads();
    }
    const int total = (int)tb[N_CVT * (int)(sizeof(CvtJob) / 4)], nh = 2 * (int)gridDim.x, hid = 2 * (int)blockIdx.x + half;
    vf4 ldA[8], ldB[8];
    int mtA = hid, mtB = hid + nh; bool actA = mtA < total, actB = mtB < total; CvtJob jbA = cvt_lookup(tb, mtA), jbB = cvt_lookup(tb, mtB);
    if (actA) cvt_mt_load(jbA, mtA - jbA.tile0, t, ldA);
    if (actB) cvt_mt_load(jbB, mtB - jbB.tile0, t, ldB);
    for (int base = 0; base < total; base += 2 * nh) {
        if (actA) cvt_mt_lds(t, ldA, tile);
        __syncthreads();
        { const int mtn = mtA + 2 * nh; const bool actn = mtn < total; const CvtJob jbn = cvt_lookup(tb, mtn);
          if (actA) cvt_mt_store(jbA, mtA - jbA.tile0, t, tile, wql);
          if (actn) cvt_mt_load(jbn, mtn - jbn.tile0, t, ldA);
          mtA = mtn; actA = actn; jbA = jbn; }
        __syncthreads();
        if (actB) cvt_mt_lds(t, ldB, tile);
        __syncthreads();
        { const int mtn = mtB + 2 * nh; const bool actn = mtn < total; const CvtJob jbn = cvt_lookup(tb, mtn);
          if (actB) cvt_mt_store(jbB, mtB - jbB.tile0, t, tile, wql);
          if (actn) cvt_mt_load(jbn, mtn - jbn.tile0, t, ldB);
          mtB = mtn; actB = actn; jbB = jbn; }
        __syncthreads();
    }
}

constexpr int NORM_LCNT = 8 * 1024 * 4;
constexpr int NORM_VEC = 40 * 1024;
template <int MODE, int FMT, bool XF32>
DEVI void ph_norm(LAS3 unsigned char* lds, const void* __restrict__ x, const float* __restrict__ g, const float* __restrict__ mod, bf16_t* __restrict__ H, const float* __restrict__ wext, const float* __restrict__ rbias,
                  float* __restrict__ gates_out, int* __restrict__ ridx, float* __restrict__ rgate, int* __restrict__ rrank, int* __restrict__ cnt, int* __restrict__ wgbase, float* __restrict__ rs_out = nullptr) {
    constexpr bool F8 = (FMT == 1);
    const int lane = tid_() & 63, wave = __builtin_amdgcn_readfirstlane(tid_() >> 6);
    constexpr int LD = (MODE == 0) ? IN_COLS : 8;
    LAS3 int* lcnt = (LAS3 int*)(lds + NORM_LCNT);
    sc::f32x4 wr[16][2];
    if (MODE != 1) {
#pragma unroll
        for (int i = 0; i < 4; ++i)
#pragma unroll
            for (int j = 0; j < 4; ++j) { const int col = XF32 ? (lane + 64 * i) * 4 + j : (lane + 64 * (i >> 1)) * 8 + 4 * (i & 1) + j; const sc::f32x4* wp = (const sc::f32x4*)(wext + (size_t)col * LD); wr[4 * i + j][0] = wp[0]; wr[4 * i + j][1] = wp[1]; }
        if (MODE == 2 && tid_() < 8) lcnt[tid_()] = 0;
        __syncthreads();
    }
    LAS3 float* gmv = (LAS3 float*)(lds + NORM_VEC); LAS3 float* shv = gmv + 1024;
    for (int pm = (int)blockIdx.x; pm < TOK / 256; pm += (int)gridDim.x) {
      { const int b = pm >> 3; const float* mb = mod + (size_t)b * 3072;
        for (int k = tid_(); k < 1024; k += 512) { gmv[k] = g[k] * (1.f + mb[1024 + k]); shv[k] = mb[k]; }
        __syncthreads(); }
      int cols[4];
#pragma unroll
      for (int i = 0; i < 4; ++i) cols[i] = XF32 ? (lane + 64 * i) * 4 : (lane + 64 * (i >> 1)) * 8 + 4 * (i & 1);
      float4 nf[4]; uint4 nw[2];
      { const int row = pm * 256 + wave;
        if (XF32) { const float4* xr = (const float4*)((const float*)x + (size_t)row * 1024);
#pragma unroll
            for (int i = 0; i < 4; ++i) nf[i] = xr[lane + 64 * i]; }
        else { const uint4* xr = (const uint4*)((const bf16_t*)x + (size_t)row * 1024);
#pragma unroll
            for (int i = 0; i < 2; ++i) nw[i] = xr[lane + 64 * i]; } }
      for (int rr = wave; rr < 256; rr += 8) {
        const int row = pm * 256 + rr;
        float4 v[4]; float ss = 0.f;
        if (XF32) {
#pragma unroll
            for (int i = 0; i < 4; ++i) v[i] = nf[i]; }
        else {
#pragma unroll
            for (int i = 0; i < 2; ++i) { const uint4 w = nw[i];
                v[2 * i] = make_float4(__uint_as_float(w.x << 16), __uint_as_float(w.x & 0xffff0000u), __uint_as_float(w.y << 16), __uint_as_float(w.y & 0xffff0000u));
                v[2 * i + 1] = make_float4(__uint_as_float(w.z << 16), __uint_as_float(w.z & 0xffff0000u), __uint_as_float(w.w << 16), __uint_as_float(w.w & 0xffff0000u)); } }
        if (rr + 8 < 256) {
            if (XF32) { const float4* xr = (const float4*)((const float*)x + (size_t)(row + 8) * 1024);
#pragma unroll
                for (int i = 0; i < 4; ++i) nf[i] = xr[lane + 64 * i]; }
            else { const uint4* xr = (const uint4*)((const bf16_t*)x + (size_t)(row + 8) * 1024);
#pragma unroll
                for (int i = 0; i < 2; ++i) nw[i] = xr[lane + 64 * i]; } }
#pragma unroll
        for (int i = 0; i < 4; ++i) ss += v[i].x * v[i].x + v[i].y * v[i].y + v[i].z * v[i].z + v[i].w * v[i].w;
        ss = wave_sum(ss);
        const float rstd = rsqrtf(ss * (1.0f / 1024.0f) + EPS);
        typedef float f32x2_t __attribute__((ext_vector_type(2)));
        f32x2_t ext2[4];
#pragma unroll
        for (int e = 0; e < 4; ++e) ext2[e] = (f32x2_t){0.f, 0.f};
        float hq[4][4]; float amax = 0.f;
#pragma unroll
        for (int i = 0; i < 4; ++i) {
            const int col = cols[i];
            const sc::f32x4 gm = *(const LAS3 sc::f32x4*)(gmv + col), sh = *(const LAS3 sc::f32x4*)(shv + col);
            float hv[4];
            hv[0] = v[i].x * rstd * gm[0] + sh[0]; hv[1] = v[i].y * rstd * gm[1] + sh[1];
            hv[2] = v[i].z * rstd * gm[2] + sh[2]; hv[3] = v[i].w * rstd * gm[3] + sh[3];
            if (FMT == 2) {
#pragma unroll
                for (int j = 0; j < 4; ++j) { hq[i][j] = hv[j]; amax = fmaxf(amax, fabsf(hv[j])); } }
            else if (F8) { unsigned q8 = 0u; q8 = __builtin_amdgcn_cvt_pk_fp8_f32(sat8(hv[0]), sat8(hv[1]), q8, false); q8 = __builtin_amdgcn_cvt_pk_fp8_f32(sat8(hv[2]), sat8(hv[3]), q8, true);
                *(unsigned*)((unsigned char*)H + (size_t)row * 1024 + col) = q8; }
            else { uint2 pk; pk.x = cvt2bf(hv[0], hv[1]); pk.y = cvt2bf(hv[2], hv[3]);
            *(uint2*)(H + (size_t)row * 1024 + col) = pk; }
            if (MODE != 1) {
#pragma unroll
                for (int j = 0; j < 4; ++j) { const f32x2_t hh = (f32x2_t){hv[j], hv[j]};
#pragma unroll
                    for (int q = 0; q < 2; ++q) { const sc::f32x4 w = wr[4 * i + j][q];
                        ext2[2 * q] = __builtin_elementwise_fma(hh, (f32x2_t){w[0], w[1]}, ext2[2 * q]); ext2[2 * q + 1] = __builtin_elementwise_fma(hh, (f32x2_t){w[2], w[3]}, ext2[2 * q + 1]); } }
            }
        }
        if (FMT == 2) {
            amax = fmaxf(wave_max(amax), 1e-30f);
            const float inv = 127.0f / amax;
#pragma unroll
            for (int i = 0; i < 4; ++i) *(unsigned*)((unsigned char*)H + (size_t)row * 1024 + cols[i]) = pack_i8x4(hq[i][0] * inv, hq[i][1] * inv, hq[i][2] * inv, hq[i][3] * inv);
            if (lane == 0) rs_out[row] = amax * (1.0f / 127.0f);
        }
        if (MODE != 1) {
            float ext[8];
            { float xs[8];
#pragma unroll
              for (int e = 0; e < 8; ++e) xs[e] = ext2[e >> 1][e & 1];
              const float tot = wave_sum8(xs, lane);
#pragma unroll
              for (int e = 0; e < 8; ++e) ext[e] = __int_as_float(__builtin_amdgcn_readlane(__float_as_int(tot), e)); }
            if (MODE == 0) { if (lane == 0) { *(float4*)(gates_out + (size_t)row * 8) = make_float4(ext[0], ext[1], ext[2], ext[3]); *(float4*)(gates_out + (size_t)row * 8 + 4) = make_float4(ext[4], ext[5], ext[6], ext[7]); } }
            else {
                float best = -3.0e38f, second = -3.0e38f; int bi = 0, si = 0;
#pragma unroll
                for (int e = 0; e < 8; ++e) { const float lv = ext[e] + rbias[e];
                    if (lv > best) { second = best; si = bi; best = lv; bi = e; } else if (lv > second) { second = lv; si = e; } }
                if (lane == 0) {
                    const float e1 = __expf(second - best), g0 = 1.0f / (1.0f + e1), g1 = e1 / (1.0f + e1);
                    ridx[row * 2] = bi; ridx[row * 2 + 1] = si; rgate[row * 2] = g0; rgate[row * 2 + 1] = g1;
                    rrank[row * 2] = atomicAdd((int*)(lcnt + bi), 1); rrank[row * 2 + 1] = atomicAdd((int*)(lcnt + si), 1);
                }
            }
        }
      }
      __syncthreads();
    }
    if (MODE == 2) {
        __syncthreads();
        if (tid_() < 8) wgbase[(int)blockIdx.x * 8 + tid_()] = atomicAdd(&cnt[tid_()], lcnt[tid_()]);
    }
}

struct MoeBases { int b[9]; };
DEVI MoeBases moe_bases(const int* __restrict__ cnt) {
    MoeBases m; int acc = 0;
#pragma unroll
    for (int e = 0; e < 8; ++e) { m.b[e] = acc; acc += (__builtin_amdgcn_readfirstlane(cnt[e]) + 255) & ~255; }
    m.b[8] = acc; return m;
}
namespace pg8 {
struct MoeOrder2 {
    MoeBases mb; int nN, G, c;
    __device__ bool next(int i, Unit& u) const {
        const int nt = mb.b[8] >> 8; const long L = (long)i * G + c; if (L >= (long)nt * nN) return false;
        const int pm = (int)(L / nN), pnl = (int)(L % nN), row = pm * 256; int e = 0;
#pragma unroll
        for (int q = 1; q < 8; ++q) e += (row >= mb.b[q]) ? 1 : 0;
        u.pm = pm; u.pn = e * nN + pnl; u.acol = 0; return true;
    }
};
}
DEVI void ph_gather(const bf16_t* __restrict__ H, const int* __restrict__ ridx, const int* __restrict__ rrank, const int* __restrict__ wgbase, const MoeBases& mb, int* __restrict__ rpos, bf16_t* __restrict__ A2, const float* __restrict__ rsH, float* __restrict__ rsE) {
    const int lane = tid_() & 63, wave = __builtin_amdgcn_readfirstlane(tid_() >> 6);
    constexpr bool B1 = (MOE_F8 || USE_I8);
    for (int t0 = 4 * ((int)blockIdx.x * 8 + wave); t0 < TOK; t0 += 4 * (int)gridDim.x * 8) {
        uint4 r0[4], r1[4];
#pragma unroll
        for (int i = 0; i < 4; ++i) {
            if (B1) r0[i] = ((const uint4*)((const unsigned char*)H + (size_t)(t0 + i) * 1024))[lane];
            else { const uint4* src = (const uint4*)(H + (size_t)(t0 + i) * 1024); r0[i] = src[lane]; r1[i] = src[lane + 64]; } }
        int pz = 0;
        if (lane < 8) { const int w = 2 * t0 + lane, t = w >> 1; const int e = ridx[w]; int base = 0;
#pragma unroll
            for (int q = 1; q < 8; ++q) base = (e == q) ? mb.b[q] : base;
            pz = base + wgbase[((t >> 8) % (int)gridDim.x) * 8 + e] + rrank[w];
            rpos[w] = pz; if (USE_I8) rsE[pz] = rsH[t]; }
#pragma unroll
        for (int j = 0; j < 8; ++j) { const int pj = __builtin_amdgcn_readlane(pz, j);
            if (B1) ((uint4*)((unsigned char*)A2 + (size_t)pj * 1024))[lane] = r0[j >> 1];
            else { uint4* dst = (uint4*)(A2 + (size_t)pj * 1024); dst[lane] = r0[j >> 1]; dst[lane + 64] = r1[j >> 1]; } }
    }
}
DEVI void ph_final(LAS3 unsigned char* lds, const bf16_t* __restrict__ x, const float* __restrict__ mod, const bf16_t* __restrict__ YE, const int* __restrict__ rpos, const float* __restrict__ rgate, const float* __restrict__ fg, float* out) {
    const int lane = tid_() & 63, wave = __builtin_amdgcn_readfirstlane(tid_() >> 6);
    LAS3 float* gtv = (LAS3 float*)lds; LAS3 float* fgv = gtv + 1024;
    for (int pm = (int)blockIdx.x; pm < TOK / 256; pm += (int)gridDim.x) {
      { const float* mb = mod + (size_t)(pm >> 3) * 3072 + 2048;
        for (int k = tid_(); k < 1024; k += 512) { gtv[k] = mb[k]; fgv[k] = fg[k]; }
        __syncthreads(); }
      for (int rr = wave; rr < 256; rr += 8) {
        const int row = pm * 256 + rr;
        const int p0 = rpos[row * 2], p1 = rpos[row * 2 + 1]; const float g0 = rgate[row * 2], g1 = rgate[row * 2 + 1];
        float4 v[4]; float ss = 0.f;
#pragma unroll
        for (int i = 0; i < 4; ++i) {
            const int col = (lane + 64 * i) * 4;
            const uint2 xw = *(const uint2*)(x + (size_t)row * 1024 + col);
            const float4 xv = make_float4(__uint_as_float(xw.x << 16), __uint_as_float(xw.x & 0xffff0000u), __uint_as_float(xw.y << 16), __uint_as_float(xw.y & 0xffff0000u));
            const sc::f32x4 gt = *(const LAS3 sc::f32x4*)(gtv + col);
            const uint2 y0 = *(const uint2*)(YE + (size_t)p0 * 1024 + col), y1 = *(const uint2*)(YE + (size_t)p1 * 1024 + col);
            v[i].x = xv.x + gt[0] * (g0 * __uint_as_float(y0.x << 16) + g1 * __uint_as_float(y1.x << 16));
            v[i].y = xv.y + gt[1] * (g0 * __uint_as_float(y0.x & 0xffff0000u) + g1 * __uint_as_float(y1.x & 0xffff0000u));
            v[i].z = xv.z + gt[2] * (g0 * __uint_as_float(y0.y << 16) + g1 * __uint_as_float(y1.y << 16));
            v[i].w = xv.w + gt[3] * (g0 * __uint_as_float(y0.y & 0xffff0000u) + g1 * __uint_as_float(y1.y & 0xffff0000u));
            ss += v[i].x * v[i].x + v[i].y * v[i].y + v[i].z * v[i].z + v[i].w * v[i].w;
        }
        ss = wave_sum(ss);
        const float rstd = rsqrtf(ss * (1.0f / 1024.0f) + EPS);
#pragma unroll
        for (int i = 0; i < 4; ++i) { const int col = (lane + 64 * i) * 4; const sc::f32x4 gg = *(const LAS3 sc::f32x4*)(fgv + col);
            *(float4*)(out + (size_t)row * 1024 + col) = make_float4(v[i].x * rstd * gg[0], v[i].y * rstd * gg[1], v[i].z * rstd * gg[2], v[i].w * rstd * gg[3]); }
      }
      __syncthreads();
    }
}

constexpr int N_PHASES = 22;
#define IN_PH(k) (ph_lo <= (k) && (k) < ph_hi)
#define SEAM(k) do { if ((k) + 1 < ph_hi) { XcdBarrier b_; b_.bar = (unsigned*)(p.ws + OFF_BAR); b_.x = xb_xcc_id(); b_.st = (volatile LAS unsigned*)(lds + LDSCTL); xcd_barrier(b_); } } while (0)
#define WSP(T, off) ((T*)(ws + (off)))
template <int l>
DEVI void layer_phases(const Params& p, LAS3 unsigned char* lds, const XcdBarrier& bar, int ph_lo, int ph_hi) {
    unsigned char* ws = p.ws;
    constexpr int pb = 1 + 10 * l;
    const int G = (int)gridDim.x, cid = (int)blockIdx.x;
    constexpr int WFMT = USE_I8 ? 2 : ((l == 1 && WIN1_F8 != 0) ? 1 : 0);
    if (IN_PH(pb + 0)) { ph_norm<0, WFMT, (l == 0)>(lds, (l == 0) ? (const void*)p.in[I_X] : (const void*)WSP(bf16_t, OFF_XB), p.in[I_NORM_MIX_G] + l * 1024, WSP(float, OFF_MOD) + (size_t)(2 * l) * 32 * 3072, WSP(bf16_t, OFF_H), p.in[I_W_IN] + (size_t)l * 1024 * IN_COLS + 3584, nullptr,
                                    WSP(float, OFF_GATES), nullptr, nullptr, nullptr, nullptr, nullptr, WSP(float, OFF_RSH)); SEAM(pb + 0); }
    constexpr bool W8 = (WFMT != 0);
    if (IN_PH(pb + 1)) { pg8::Gemm g{WSP(bf16_t, OFF_H), WSP(bf16_t, OFF_WEIGHTS) + WT_IN + (size_t)l * 5632 * 1024, W8 ? 512 : 1024, W8 ? 512 : 1024, WSP(float, OFF_RSH), WSP(float, OFF_WSTEP) + 3 * l, WSP(float, OFF_WSTEP) + 3 * l}; pg8::StaticOrder S; S.init(TOK, 3584, G, cid);
        pg8::FEpiWinA e{WSP(bf16_t, OFF_QM), WSP(float, OFF_LF), WSP(bf16_t, OFF_HI), WSP(bf16_t, OFF_HG), WSP(bf16_t, OFF_MU), WSP(bf16_t, OFF_MV), WSP(float, OFF_LBT) + l * 512, WFMT == 1 ? 1.0f / (float)(1 << W13_F8) : 1.0f};
        pg8::gemm_phase<pg8::FEpiWinA, pg8::StaticOrder, WFMT>(lds, g, S, e); SEAM(pb + 1); }
    if (IN_PH(pb + 2)) {
        sc::ScanArgs sa{WSP(bf16_t, OFF_QM), WSP(bf16_t, OFF_QM), WSP(float, OFF_LF), WSP(bf16_t, OFF_HI), WSP(bf16_t, OFF_HG), WSP(bf16_t, OFF_MU), WSP(bf16_t, OFF_MV), WSP(float, OFF_GATES),
                        p.in[I_HG_NORM] + l * 512, p.in[I_ML_NORM] + l * 512, p.in[I_CONV_W] + l * 4 * 512, p.in[I_CONV_B] + l * 512,
                        p.in[I_WQ] + (size_t)l * 4 * 128 * 64, p.in[I_WK] + (size_t)l * 4 * 128 * 64, p.in[I_FBIAS] + l * 4, nullptr};
        for (int it = cid; it < 256; it += G) { sc::scan_item(lds, sa, it); __syncthreads(); }
        SEAM(pb + 2); }
    if (IN_PH(pb + 3)) { pg8::Gemm g{WSP(bf16_t, OFF_H), WSP(bf16_t, OFF_WEIGHTS) + WT_IN + (size_t)l * 5632 * 1024 + (W8 ? 3584ull * 512 : 3584ull * 1024), W8 ? 512 : 1024, W8 ? 512 : 1024, WSP(float, OFF_RSH), WSP(float, OFF_WSTEP) + 3 * l + 1, WSP(float, OFF_WSTEP) + 3 * l + 2}; pg8::StaticOrder S; S.init(TOK, 2048, G, cid);
        pg8::FEpiWinG e{WSP(bf16_t, OFF_GA), WSP(bf16_t, OFF_GB), WFMT == 1 ? 1.0f / (float)(1 << W13_F8) : 1.0f};
        pg8::gemm_phase<pg8::FEpiWinG, pg8::StaticOrder, WFMT>(lds, g, S, e); SEAM(pb + 3); }
    if (IN_PH(pb + 4)) {
        pg8::Gemm g{WSP(bf16_t, OFF_QM), WSP(bf16_t, OFF_WEIGHTS) + WT_BRH + (size_t)l * 1024 * 512, 512, 1024}; pg8::BrOrder S; S.init(TOK, 1024, G, cid);
        pg8::FEpiBrG e{WSP(bf16_t, OFF_GA), WSP(bf16_t, OFF_GB), WSP(bf16_t, OFF_MERGED), OUT_F8 != 0, (float)(1 << OUT_A_SH)};
        pg8::gemm_phase<pg8::FEpiBrG, pg8::BrOrder>(lds, g, S, e);
        SEAM(pb + 4); }
    if (IN_PH(pb + 5)) { pg8::Gemm g{WSP(bf16_t, OFF_MERGED), WSP(bf16_t, OFF_WEIGHTS) + WT_OUT + (size_t)l * 1024 * (OUT_F8 ? 512 : 1024), OUT_F8 ? 512 : 1024, OUT_F8 ? 512 : 1024}; pg8::StaticOrder S; S.init(TOK, 1024, G, cid);
        pg8::FEpiResidT<(l == 0)> e{(l == 0) ? (const void*)p.in[I_X] : (const void*)WSP(bf16_t, OFF_XB), WSP(bf16_t, OFF_XB), WSP(float, OFF_MOD) + (size_t)(2 * l) * 32 * 3072, OUT_F8 ? 1.0f / (float)(1 << (W13_F8 + OUT_A_SH)) : 1.0f};
        pg8::gemm_phase<pg8::FEpiResidT<(l == 0)>, pg8::StaticOrder, OUT_F8 != 0>(lds, g, S, e); SEAM(pb + 5); }
    if (l == 0) {
        constexpr int DFMT = USE_I8 ? 2 : (DENSE_F8 ? 1 : 0);
        if (IN_PH(pb + 6)) { ph_norm<1, DFMT, false>(lds, WSP(bf16_t, OFF_XB), p.in[I_NORM_FFN_G] + l * 1024, WSP(float, OFF_MOD) + (size_t)(2 * l + 1) * 32 * 3072, WSP(bf16_t, OFF_H), nullptr, nullptr, nullptr, nullptr, nullptr, nullptr, nullptr, nullptr, WSP(float, OFF_RSH)); SEAM(pb + 6); }
        if (IN_PH(pb + 7)) { pg8::Gemm g{WSP(bf16_t, OFF_H), WSP(bf16_t, OFF_WEIGHTS) + WT_F13, DFMT ? 512 : 1024, DFMT ? 512 : 1024, WSP(float, OFF_RSH), WSP(float, OFF_WSTEP) + 9, WSP(float, OFF_WSTEP) + 10}; pg8::StaticOrder S; S.init(TOK, 5632, G, cid); pg8::FEpiSwigluT<DENSED_F8 != 0> e{WSP(bf16_t, OFF_U), D_FF, 22, DFMT == 1 ? 1.0f / (float)(1 << W13_F8) : 1.0f, 0};
            pg8::gemm_phase<pg8::FEpiSwigluT<DENSED_F8 != 0>, pg8::StaticOrder, DFMT>(lds, g, S, e); SEAM(pb + 7); }
        if (IN_PH(pb + 8)) { pg8::Gemm g{WSP(bf16_t, OFF_U), WSP(bf16_t, OFF_WEIGHTS) + WT_F2, DENSED_F8 ? D_FF / 2 : D_FF, DENSED_F8 ? D_FF / 2 : D_FF}; pg8::StaticOrder S; S.init(TOK, 1024, G, cid);
            pg8::FEpiResidT<false> e{WSP(bf16_t, OFF_XB), WSP(bf16_t, OFF_XB), WSP(float, OFF_MOD) + (size_t)(2 * l + 1) * 32 * 3072, DENSED_F8 ? 1.0f / (float)(1 << W2_F8) : 1.0f};
            pg8::gemm_phase<pg8::FEpiResidT<false>, pg8::StaticOrder, DENSED_F8 != 0>(lds, g, S, e); SEAM(pb + 8); }
        if (IN_PH(pb + 9)) { SEAM(pb + 9); }
    } else {
        constexpr int MFMT = USE_I8 ? 2 : (MOE_F8 ? 1 : 0);
        if (IN_PH(pb + 6)) { ph_norm<2, MFMT, false>(lds, WSP(bf16_t, OFF_XB), p.in[I_NORM_FFN_G] + l * 1024, WSP(float, OFF_MOD) + (size_t)(2 * l + 1) * 32 * 3072, WSP(bf16_t, OFF_H), p.in[I_RW], p.in[I_RB], nullptr,
                                        WSP(int, OFF_RIDX), WSP(float, OFF_RGATE), WSP(int, OFF_RRANK), WSP(int, OFF_MOECNT), WSP(int, OFF_MOECTL) + 1024, WSP(float, OFF_RSH)); SEAM(pb + 6); }
        if (IN_PH(pb + 7)) { const MoeBases mb = moe_bases(WSP(int, OFF_MOECNT)); ph_gather(WSP(bf16_t, OFF_H), WSP(int, OFF_RIDX), WSP(int, OFF_RRANK), WSP(int, OFF_MOECTL) + 1024, mb, WSP(int, OFF_RPOS), WSP(bf16_t, OFF_A2), WSP(float, OFF_RSH), WSP(float, OFF_RSE)); SEAM(pb + 7); }
        if (IN_PH(pb + 8)) { const MoeBases mb = moe_bases(WSP(int, OFF_MOECNT)); pg8::Gemm g{WSP(bf16_t, OFF_A2), WSP(bf16_t, OFF_WEIGHTS) + WT_M13, MFMT ? 512 : 1024, MFMT ? 512 : 1024, WSP(float, OFF_RSE), WSP(float, OFF_WSTEP) + 12, WSP(float, OFF_WSTEP) + 13}; pg8::MoeOrder2 S{mb, 11, G, cid}; pg8::FEpiSwigluT<MOED_F8 != 0> e{WSP(bf16_t, OFF_UE), MOED_F8 ? KD8 : D_FFE, 11, MFMT == 1 ? 1.0f / (float)(1 << W13_F8) : 1.0f, 1};
            pg8::gemm_phase<pg8::FEpiSwigluT<MOED_F8 != 0>, pg8::MoeOrder2, MFMT>(lds, g, S, e); SEAM(pb + 8); }
        if (IN_PH(pb + 9)) { const MoeBases mb = moe_bases(WSP(int, OFF_MOECNT)); pg8::Gemm g{WSP(bf16_t, OFF_UE), WSP(bf16_t, OFF_WEIGHTS) + WT_M2, MOED_F8 ? KD8 / 2 : D_FFE, MOED_F8 ? KD8 / 2 : D_FFE}; pg8::MoeOrder2 S{mb, 4, G, cid}; pg8::FEpiStoreBf e{WSP(bf16_t, OFF_A2), 1024, 4, MOED_F8 ? 1.0f / (float)(1 << W2_F8) : 1.0f};
            pg8::gemm_phase<pg8::FEpiStoreBf, pg8::MoeOrder2, MOED_F8 != 0>(lds, g, S, e); SEAM(pb + 9); }
    }
}
__global__ void __launch_bounds__(512, 2) k_mega(Params p, int ph_lo, int ph_hi) {
    LAS3 unsigned char* lds = (LAS3 unsigned char*)g_shm;
    if ((threadIdx.x & 63) == 0) ((LAS3 int*)(lds + LDS_WAVETAB))[hw_wave_key()] = (int)(threadIdx.x >> 6);
    unsigned char* ws = p.ws;
    if (threadIdx.x < 4) ((LAS3 unsigned*)(lds + LDSCTL))[threadIdx.x] = 0u;
    __syncthreads();
    XcdBarrier bar; bar.bar = (unsigned*)(ws + OFF_BAR); bar.x = 0; bar.st = nullptr;
    if (ph_hi - ph_lo > 1) bar = xcd_barrier_post((unsigned*)(ws + OFF_BAR), (volatile LAS unsigned*)(lds + LDSCTL));
    if (IN_PH(0)) { ph_prologue(p, lds); SEAM(0); }
    layer_phases<0>(p, lds, bar, ph_lo, ph_hi);
    layer_phases<1>(p, lds, bar, ph_lo, ph_hi);
    if (IN_PH(21)) ph_final(lds, WSP(bf16_t, OFF_XB), WSP(float, OFF_MOD) + (size_t)3 * 32 * 3072, WSP(bf16_t, OFF_A2), WSP(int, OFF_RPOS), WSP(float, OFF_RGATE), p.in[I_FINAL_G], p.out);
}
#undef IN_PH
#undef SEAM

#ifndef MK_PER_PHASE
#define MK_PER_PHASE 0
#endif
extern "C" void kernel_launch(void* const* d_in, const int* in_sizes, int n_in, void* d_out, int out_size, void* d_ws, size_t ws_size, hipStream_t stream) {
    (void)in_sizes; (void)out_size; (void)ws_size;
    static int grid = 0;
    if (grid == 0) {
        int dev = 0, cus = 0, per_cu = 0;
        (void)hipGetDevice(&dev); (void)hipDeviceGetAttribute(&cus, hipDeviceAttributeMultiprocessorCount, dev);
        (void)hipFuncSetAttribute((const void*)k_mega, hipFuncAttributeMaxDynamicSharedMemorySize, LDS_BYTES);
        (void)hipOccupancyMaxActiveBlocksPerMultiprocessor(&per_cu, (const void*)k_mega, 512, LDS_BYTES);
        (void)hipGetLastError();
        grid = (cus > 0 && cus < 256) ? cus : 256;
        if (per_cu < 1) grid = 256;
    }
    char* ws = (char*)d_ws;
    (void)hipMemsetAsync(ws + OFF_CTR, 0, 4096 + XCD_BAR_WORDS * 4, stream);
    Params p; memset(&p, 0, sizeof(p));
    for (int i = 0; i < N_IN && i < n_in; ++i) p.in[i] = (const float*)d_in[i];
    p.out = (float*)d_out; p.ws = (unsigned char*)d_ws;
    {
        bf16_t* WT = (bf16_t*)(ws + OFF_WEIGHTS);
        CvtJobs& J = p.J; int nj = 0, tiles = 0;
        auto add = [&](const float* src, bf16_t* dst, int K, int ncols, int ldsrc, int nb, long long sb, int drpb, int mode, int f8 = 0, int dst_ld = 0) {
            CvtJob& q = J.j[nj++]; q.src = src; q.dst = dst; q.K = K; q.ncols = ncols; q.ldsrc = ldsrc; q.nb = nb; q.src_bstride = sb; q.dst_rows_per_batch = drpb; q.mode = mode; q.f8 = f8; q.dst_ld = dst_ld ? dst_ld : K; q.pad = 0; q.tile0 = tiles; tiles += nb * (K / 64) * (ncols / 128); };
        for (int l = 0; l < 2; ++l) {
            const int f = USE_I8 ? I8_FLAG : ((l == 1 && WIN1_F8) ? W13_F8 : 0);
            const float* w = p.in[I_W_IN] + (size_t)l * 1024 * IN_COLS; bf16_t* d = WT + WT_IN + (size_t)l * 5632 * 1024;
            bf16_t* dg = f ? (bf16_t*)((unsigned char*)d + 3584ull * 1024) : d + 3584ull * 1024;
            add(w, d, 1024, 3584, IN_COLS, 1, 0, 0, 0, f);
            add(w + 3592, dg, 1024, 1024, IN_COLS, 1, 0, 0, 1, f);
            add(w + 3592 + 1024, dg, 1024, 1024, IN_COLS, 1, 0, 0, 2, f);
        }
        add(p.in[I_BRH], WT + WT_BRH, 512, 1024, 1024, 2, 512ll * 1024, 1024, 0);
        add(p.in[I_BRM], WT + WT_BRM, 512, 1024, 1024, 2, 512ll * 1024, 1024, 0);
        add(p.in[I_WOUT], WT + WT_OUT, 1024, 1024, 1024, 2, 1024ll * 1024, 1024, 0, OUT_F8 ? W13_F8 : 0);
        add(p.in[I_FW1], WT + WT_F13, 1024, D_FF, D_FF, 1, 0, 0, 1, USE_I8 ? I8_FLAG : (DENSE_F8 ? W13_F8 : 0));
        add(p.in[I_FW3], WT + WT_F13, 1024, D_FF, D_FF, 1, 0, 0, 2, USE_I8 ? I8_FLAG : (DENSE_F8 ? W13_F8 : 0));
        add(p.in[I_FW2], WT + WT_F2, D_FF, 1024, 1024, 1, 0, 0, 0, DENSED_F8 ? W2_F8 : 0);
        add(p.in[I_MW1], WT + WT_M13, 1024, D_FFE, D_FFE, 8, 1024ll * D_FFE, 2816, 1, USE_I8 ? I8_FLAG : (MOE_F8 ? W13_F8 : 0));
        add(p.in[I_MW3], WT + WT_M13, 1024, D_FFE, D_FFE, 8, 1024ll * D_FFE, 2816, 2, USE_I8 ? I8_FLAG : (MOE_F8 ? W13_F8 : 0));
        add(p.in[I_MW2], WT + WT_M2, D_FFE, 1024, 1024, 8, (long long)D_FFE * 1024, 1024, 0, MOED_F8 ? W2_F8 : 0, MOED_F8 ? KD8 : 0);
        for (int q = nj; q < N_CVT; ++q) { J.j[q] = J.j[nj - 1]; J.j[q].tile0 = 0x7fffffff; }
        J.total_tiles = tiles;
    }
    if (MK_PER_PHASE) { for (int ph = 0; ph < N_PHASES; ++ph) hipLaunchKernelGGL(k_mega, dim3(grid), dim3(512), LDS_BYTES, stream, p, ph, ph + 1); }
    else hipLaunchKernelGGL(k_mega, dim3(grid), dim3(512), LDS_BYTES, stream, p, 0, N_PHASES);
}
```

```cpp
#include <hip/hip_runtime.h>
#include <stdint.h>
#include <stddef.h>
#include <string.h>
#define LAS3 __attribute__((address_space(3)))

typedef unsigned short bf16_t;
#define DEVI __device__ __forceinline__

constexpr int D_MODEL = 1024, BATCH = 32, SEQL = 2048, TOK = BATCH * SEQL;
constexpr int IN_COLS = 5640;
constexpr int D_FF = 2816, N_EXP = 8, D_FFE = 1408;
constexpr float EPS = 1e-6f;
constexpr int MOE_ROWS = 2 * TOK + N_EXP * 256;

constexpr size_t MiB = 1024ull * 1024ull;
constexpr size_t OFF_MISC = 0;
constexpr size_t OFF_MOD = OFF_MISC + 64 * 1024;
constexpr size_t OFF_GATES = OFF_MISC + 2 * MiB;
constexpr size_t OFF_RIDX = OFF_MISC + 4 * MiB;
constexpr size_t OFF_RGATE = OFF_MISC + 5 * MiB;
constexpr size_t OFF_RRANK = OFF_MISC + 6 * MiB;
constexpr size_t OFF_RPOS = OFF_MISC + 7 * MiB;
constexpr size_t OFF_MOECTL = OFF_MISC + 8 * MiB;
constexpr size_t OFF_WEIGHTS = 16 * MiB;
constexpr size_t OFF_H = OFF_WEIGHTS + 120 * MiB;
constexpr size_t OFF_QM = OFF_H + 128 * MiB;
constexpr size_t OFF_LF = OFF_QM + 128 * MiB;
constexpr size_t OFF_HI = OFF_LF + 128 * MiB;
constexpr size_t OFF_HG = OFF_HI + 64 * MiB;
constexpr size_t OFF_MU = OFF_HG + 64 * MiB;
constexpr size_t OFF_MV = OFF_MU + 64 * MiB;
constexpr size_t OFF_UC = OFF_MV + 64 * MiB;
constexpr size_t OFF_QQ = OFF_UC + 64 * MiB;
constexpr size_t OFF_KK = OFF_QQ + 32 * MiB;
constexpr size_t OFF_END = OFF_KK + 32 * MiB;
constexpr size_t OFF_XB = OFF_UC;
constexpr size_t OFF_GA = OFF_LF;
constexpr size_t OFF_GB = OFF_HI;
constexpr size_t OFF_MERGED = OFF_MU;
constexpr size_t OFF_U = OFF_QM;
constexpr size_t OFF_A2 = OFF_QM;
constexpr size_t OFF_UE = OFF_QM + 260 * MiB;
static_assert(OFF_UE + (size_t)MOE_ROWS * D_FFE * 2 <= OFF_END, "moe overlay");
static_assert(OFF_END <= 1024 * MiB, "ws");

typedef __bf16 nbf16x2 __attribute__((ext_vector_type(2)));
typedef float nf32x2 __attribute__((ext_vector_type(2)));
DEVI unsigned cvt2bf(float lo, float hi) { nf32x2 f = {lo, hi}; return __builtin_bit_cast(unsigned, __builtin_convertvector(f, nbf16x2)); }
DEVI bf16_t f2bf(float f) { return (bf16_t)(cvt2bf(f, 0.f) & 0xffffu); }
DEVI float bf2f(bf16_t b) { return __uint_as_float(((unsigned)b) << 16); }
DEVI float sigmoidf_(float z) { return __builtin_amdgcn_rcpf(1.0f + __expf(-z)); }
DEVI float siluf_(float z) { return z * __builtin_amdgcn_rcpf(1.0f + __expf(-z)); }
template <int CTRL, int ROWMASK> DEVI float dpp_mov(float old, float v) { return __int_as_float(__builtin_amdgcn_update_dpp(__float_as_int(old), __float_as_int(v), CTRL, ROWMASK, 0xf, false)); }
DEVI float wave_sum(float v) {
    v += dpp_mov<0xB1, 0xf>(0.f, v);
    v += dpp_mov<0x4E, 0xf>(0.f, v);
    v += dpp_mov<0x141, 0xf>(0.f, v);
    v += dpp_mov<0x140, 0xf>(0.f, v);
    v += dpp_mov<0x142, 0xa>(0.f, v);
    v += dpp_mov<0x143, 0xc>(0.f, v);
    return __int_as_float(__builtin_amdgcn_readlane(__float_as_int(v), 63));
}
DEVI float wave_max(float v) {
    v = fmaxf(v, dpp_mov<0xB1, 0xf>(v, v));
    v = fmaxf(v, dpp_mov<0x4E, 0xf>(v, v));
    v = fmaxf(v, dpp_mov<0x141, 0xf>(v, v));
    v = fmaxf(v, dpp_mov<0x140, 0xf>(v, v));
    v = fmaxf(v, dpp_mov<0x142, 0xa>(v, v));
    v = fmaxf(v, dpp_mov<0x143, 0xc>(v, v));
    return __int_as_float(__builtin_amdgcn_readlane(__float_as_int(v), 63));
}
DEVI float wave_sum8(const float (&x)[8], int lane) {
    const bool b2 = lane & 4, b1 = lane & 2, b0 = lane & 1;
    float r1[4], r2[2];
#pragma unroll
    for (int k = 0; k < 4; ++k) r1[k] = (b2 ? x[4 + k] : x[k]) + dpp_mov<0x141, 0xf>(0.f, b2 ? x[k] : x[4 + k]);
#pragma unroll
    for (int k = 0; k < 2; ++k) r2[k] = (b1 ? r1[2 + k] : r1[k]) + dpp_mov<0x4E, 0xf>(0.f, b1 ? r1[k] : r1[2 + k]);
    float r = (b0 ? r2[1] : r2[0]) + dpp_mov<0xB1, 0xf>(0.f, b0 ? r2[0] : r2[1]);
    r += dpp_mov<0x128, 0xf>(0.f, r);
    r += __shfl_xor(r, 16); r += __shfl_xor(r, 32);
    return r;
}
DEVI float wave_scan_sum(float v) {
    v += dpp_mov<0x111, 0xf>(0.f, v); v += dpp_mov<0x112, 0xf>(0.f, v); v += dpp_mov<0x114, 0xf>(0.f, v); v += dpp_mov<0x118, 0xf>(0.f, v);
    v += dpp_mov<0x142, 0xa>(0.f, v); v += dpp_mov<0x143, 0xc>(0.f, v);
    return v;
}
DEVI float wave_scan_max(float v) {
    const float ninf = -3.0e38f;
    v = fmaxf(v, dpp_mov<0x111, 0xf>(ninf, v)); v = fmaxf(v, dpp_mov<0x112, 0xf>(ninf, v)); v = fmaxf(v, dpp_mov<0x114, 0xf>(ninf, v)); v = fmaxf(v, dpp_mov<0x118, 0xf>(ninf, v));
    v = fmaxf(v, dpp_mov<0x142, 0xa>(ninf, v)); v = fmaxf(v, dpp_mov<0x143, 0xc>(ninf, v));
    return v;
}
DEVI float lane63(float v) { return __int_as_float(__builtin_amdgcn_readlane(__float_as_int(v), 63)); }
DEVI unsigned pack_i8x4(float a, float b, float c, float d) {
    const unsigned ua = __float_as_uint(a + 12582912.0f), ub = __float_as_uint(b + 12582912.0f), uc = __float_as_uint(c + 12582912.0f), ud = __float_as_uint(d + 12582912.0f);
    return __builtin_amdgcn_perm(ub, ua, 0x0c0c0400u) | __builtin_amdgcn_perm(ud, uc, 0x04000c0cu);
}
DEVI float sat8(float x) { return __builtin_amdgcn_fmed3f(x, -448.0f, 448.0f); }
DEVI float tof(float v) { return v; }
DEVI float tof(bf16_t v) { return bf2f(v); }

extern __shared__ __attribute__((aligned(16))) unsigned char g_shm[];
constexpr int LDS_WAVETAB = 128 * 1024 + 64;
DEVI unsigned hw_wave_key() { return (unsigned)__builtin_amdgcn_s_getreg((5 << 11) | 4) & 63u; }
DEVI int lane_id_() { return (int)__builtin_amdgcn_mbcnt_hi(~0u, __builtin_amdgcn_mbcnt_lo(~0u, 0u)); }
DEVI int wave_id_() { return __builtin_amdgcn_readfirstlane(((const LAS3 int*)((LAS3 unsigned char*)g_shm + LDS_WAVETAB))[hw_wave_key()]); }
DEVI int tid_() { return wave_id_() * 64 + lane_id_(); }

namespace pg8 {
#define PG8_LAS __attribute__((address_space(3)))
typedef short bf16x8 __attribute__((ext_vector_type(8)));
typedef float f32x4 __attribute__((ext_vector_type(4)));
typedef unsigned u32x4 __attribute__((ext_vector_type(4)));
constexpr int BM = 256, BK = 64, HALF = 128, HTB = HALF * BK * 2, STAGE_BYTES = 8 * HTB, NXCD = 8, WGM = 8;
__host__ __device__ __forceinline__ int lds_byte(int r, int c) { const int st = (r >> 4) * 2 + (c >> 5), rr = r & 15, cc = c & 31, ob = rr * 64 + cc * 2; return st * 1024 + (ob ^ (((ob >> 9) & 1) << 5)); }
__host__ __device__ __forceinline__ void stage_rc(int b, int& R, int& C) { const int st = b / 1024, sb = b % 1024, swz = sb ^ (((sb >> 9) & 1) << 5); R = (st >> 1) * 16 + swz / 64; C = (st & 1) * 32 + (swz % 64) / 2; }
__host__ __device__ __forceinline__ int perm32(int rho) { const int n = rho >> 4, i = rho & 15; return 8 * (i >> 2) + 4 * n + (i & 3); }
struct Unit { int pm, pn, acol; };
struct Gemm { const bf16_t* A; const bf16_t* Bt; int K, lda; const float* rs = nullptr; const float* ws0 = nullptr; const float* ws1 = nullptr; unsigned akstep = 0; };
struct StaticOrder {
    int nM, nN, nwg, G, c;
    __device__ void init(int M, int N, int G_, int c_) { nM = M / BM; nN = N / BM; nwg = nM * nN; G = G_; c = c_; }
    __device__ bool next(int i, Unit& u) const {
        const long L = (long)i * G + c; if (L >= nwg) return false;
        int wgid = (int)L; { const int q = nwg / NXCD, r = nwg % NXCD, xcd = wgid % NXCD, off = wgid / NXCD; wgid = (xcd < r ? xcd * (q + 1) : r * (q + 1) + (xcd - r) * q) + off; }
        const int nig = WGM * nN, gid = wgid / nig, fm = gid * WGM, gsz = (nM - fm) < WGM ? (nM - fm) : WGM;
        u.pm = fm + ((wgid % nig) % gsz); u.pn = (wgid % nig) / gsz; u.acol = 0; return true;
    }
};
struct BrOrder : StaticOrder {
    __device__ bool next(int i, Unit& u) const { if (!StaticOrder::next(i >> 1, u)) return false; if (i & 1) { u.pn += 8; u.acol = 1024; } return true; }
};
struct MoeOrder {
    const int* ctl; int nN, G, c;
    __device__ bool next(int i, Unit& u) const {
        const int nt = __builtin_amdgcn_readfirstlane(ctl[128]); const long L = (long)i * G + c; if (L >= (long)nt * nN) return false;
        const int pm = (int)(L / nN), pnl = (int)(L % nN); u.pm = pm; u.pn = __builtin_amdgcn_readfirstlane(ctl[4096 + pm]) * nN + pnl; u.acol = 0; return true;
    }
};
__device__ __forceinline__ unsigned cvt_pk_bf16(float lo, float hi) { return cvt2bf(lo, hi); }
__device__ __forceinline__ u32x4 pack8(const f32x4 a, const f32x4 b) { u32x4 w; w.x = cvt_pk_bf16(a[0], a[1]); w.y = cvt_pk_bf16(a[2], a[3]); w.z = cvt_pk_bf16(b[0], b[1]); w.w = cvt_pk_bf16(b[2], b[3]); return w; }
__device__ __forceinline__ void unpack8(const u32x4 w, f32x4& a, f32x4& b) {
    a[0] = __uint_as_float(w.x << 16); a[1] = __uint_as_float(w.x & 0xffff0000u); a[2] = __uint_as_float(w.y << 16); a[3] = __uint_as_float(w.y & 0xffff0000u);
    b[0] = __uint_as_float(w.z << 16); b[1] = __uint_as_float(w.z & 0xffff0000u); b[2] = __uint_as_float(w.w << 16); b[3] = __uint_as_float(w.w & 0xffff0000u); }

typedef int i32x4 __attribute__((ext_vector_type(4)));
typedef int i32x8 __attribute__((ext_vector_type(8)));
__device__ __forceinline__ i32x8 cat8(bf16x8 lo, bf16x8 hi) { return __builtin_shufflevector(__builtin_bit_cast(i32x4, lo), __builtin_bit_cast(i32x4, hi), 0, 1, 2, 3, 4, 5, 6, 7); }
__device__ __forceinline__ const char* uni(const char* p) { unsigned long long v = (unsigned long long)p; asm volatile("" : "+s"(v)); return (const char*)v; }
template <class Epi, class Sched, int FMT = 0>
__device__ __forceinline__ void gemm_phase(PG8_LAS unsigned char* lds, const Gemm g, const Sched& S, const Epi& E) {
    constexpr bool FP8 = (FMT == 1);
    const int tid = tid_(), wid = __builtin_amdgcn_readfirstlane(tid >> 6), lane = tid & 63, wr = wid >> 2, wc = wid & 3, fr = lane & 15, fq = lane >> 4;
    const int K = g.K, nt = K / BK, lda = g.lda;
    unsigned voffA[2], voffB[2];
#pragma unroll
    for (int i = 0; i < 2; ++i) { int R, C; stage_rc(tid * 16 + i * 8192, R, C); const int Rb = Epi::PERM ? ((R & ~31) + perm32(R & 31)) : R;
        voffA[i] = (unsigned)(R * lda + C) * 2u; voffB[i] = (unsigned)(Rb * K + C) * 2u; }
    constexpr unsigned kstep = (unsigned)(BK * 2);
    const unsigned akstep = g.akstep ? g.akstep : kstep;
    const unsigned hstepA = (unsigned)HALF * (unsigned)lda * 2u, hstepB = (unsigned)HALF * (unsigned)K * 2u;
    const size_t tstepA = 2 * (size_t)hstepA, tstepB = 2 * (size_t)hstepB;
    const unsigned ldsw = (unsigned)wid * 1024u;
    const int aoff = lds_byte(wr * 64 + fr, fq * 8), boff = lds_byte(wc * 32 + fr, fq * 8);
#define PG8_SA(b, h) (((b) * 2 + (h)) * HTB)
#define PG8_SB(b, h) ((4 + (b) * 2 + (h)) * HTB)
#define PG8_STAGE(bufoff, gbase, voff) do { _Pragma("unroll") for (int _i = 0; _i < 2; ++_i) \
        __builtin_amdgcn_global_load_lds((const unsigned*)((const char*)(gbase) + (voff)[_i]), (PG8_LAS unsigned*)(lds + (bufoff) + ldsw + _i * 8192), 16, 0, 0); } while (0)
#define PG8_LDA(dst, b, h) do { _Pragma("unroll") for (int m = 0; m < 4; ++m) { \
        if constexpr (FP8) dst##8[m] = cat8(*(const PG8_LAS bf16x8*)(lds + PG8_SA(b, h) + aoff + m * 2048), *(const PG8_LAS bf16x8*)(lds + PG8_SA(b, h) + aoff + m * 2048 + 1024)); \
        else { _Pragma("unroll") for (int k = 0; k < 2; ++k) dst[m][k] = *(const PG8_LAS bf16x8*)(lds + PG8_SA(b, h) + aoff + m * 2048 + k * 1024); } } } while (0)
#define PG8_LDB(dst, b, h) do { _Pragma("unroll") for (int n = 0; n < 2; ++n) { \
        if constexpr (FP8) dst##8[n] = cat8(*(const PG8_LAS bf16x8*)(lds + PG8_SB(b, h) + boff + n * 2048), *(const PG8_LAS bf16x8*)(lds + PG8_SB(b, h) + boff + n * 2048 + 1024)); \
        else { _Pragma("unroll") for (int k = 0; k < 2; ++k) dst[n][k] = *(const PG8_LAS bf16x8*)(lds + PG8_SB(b, h) + boff + n * 2048 + k * 1024); } } } while (0)
#define PG8_MMA(ai, bj, At, Bt) do { __builtin_amdgcn_s_setprio(1); _Pragma("unroll") for (int m = 0; m < 4; ++m) _Pragma("unroll") for (int n = 0; n < 2; ++n) { \
        if constexpr (FP8) asm volatile("v_mfma_f32_16x16x128_f8f6f4 %0, %1, %2, %0" : "+v"(acc[ai][bj][m][n]) : "v"(Bt##8[n]), "v"(At##8[m]));   \
        else if constexpr (FMT == 2) { _Pragma("unroll") for (int k = 0; k < 2; ++k) acc[ai][bj][m][n] = __builtin_bit_cast(f32x4, __builtin_amdgcn_mfma_i32_16x16x64_i8(__builtin_bit_cast(i32x4, Bt[n][k]), __builtin_bit_cast(i32x4, At[m][k]), __builtin_bit_cast(i32x4, acc[ai][bj][m][n]), 0, 0, 0)); } \
        else { _Pragma("unroll") for (int k = 0; k < 2; ++k) acc[ai][bj][m][n] = __builtin_amdgcn_mfma_f32_16x16x32_bf16(Bt[n][k], At[m][k], acc[ai][bj][m][n], 0, 0, 0); } } \
        __builtin_amdgcn_s_setprio(0); } while (0)
#define PG8_WAIT_V(n) asm volatile("s_waitcnt vmcnt(" #n ")" ::: "memory")
#define PG8_WAIT_L(n) asm volatile("s_waitcnt lgkmcnt(" #n ")" ::: "memory")
#define PG8_BAR __builtin_amdgcn_s_barrier()
#define PG8_SCHED __builtin_amdgcn_sched_barrier(0)
    Unit cur, nxt; int ui = 0;
    if (!S.next(0, cur)) return;
    f32x4 acc[2][2][4][2];
#pragma unroll
    for (int a = 0; a < 2; ++a)
#pragma unroll
        for (int b = 0; b < 2; ++b)
#pragma unroll
            for (int m = 0; m < 4; ++m)
#pragma unroll
                for (int n = 0; n < 2; ++n) acc[a][b][m][n] = (f32x4){0.f, 0.f, 0.f, 0.f};
    bf16x8 At[4][2], B0[2][2], B1[2][2];
    i32x8 At8[4], B08[2], B18[2];
    const char* cA = (const char*)g.A + (size_t)cur.pm * tstepA + cur.acol; const char* cB = (const char*)g.Bt + (size_t)cur.pn * tstepB;
    PG8_STAGE(PG8_SB(0, 0), cB, voffB); PG8_STAGE(PG8_SA(0, 0), cA, voffA); PG8_STAGE(PG8_SB(0, 1), cB + hstepB, voffB); PG8_STAGE(PG8_SA(0, 1), cA + hstepA, voffA);
    if (wr == 1) PG8_BAR;
    PG8_WAIT_V(4); PG8_BAR;
    PG8_STAGE(PG8_SB(1, 0), cB + kstep, voffB); PG8_STAGE(PG8_SA(1, 0), cA + akstep, voffA); PG8_STAGE(PG8_SB(1, 1), cB + hstepB + kstep, voffB);
    PG8_WAIT_V(6); PG8_BAR;
    for (;;) {
        const bool has_next = S.next(ui + 1, nxt);
        const char* nA = has_next ? (const char*)g.A + (size_t)nxt.pm * tstepA + nxt.acol : cA; const char* nB = has_next ? (const char*)g.Bt + (size_t)nxt.pn * tstepB : cB;
#pragma unroll 1
        for (int t = 0; t < nt; t += 2) {
            const bool last = (t == nt - 2);
            const char* a1 = uni(cA + (size_t)(t + 1) * akstep);
            const char* a2 = uni(last ? nA : cA + (size_t)(t + 2) * akstep); const char* b2 = uni(last ? nB : cB + (size_t)(t + 2) * kstep);
            const char* a3 = a2 + akstep; const char* b3 = b2 + kstep;
            PG8_LDB(B0, 0, 0); PG8_SCHED; PG8_LDA(At, 0, 0); PG8_STAGE(PG8_SA(1, 1), a1 + hstepA, voffA);
            PG8_WAIT_L(8); PG8_BAR; PG8_WAIT_L(0); PG8_MMA(0, 0, At, B0); PG8_BAR; PG8_SCHED;
            PG8_LDB(B1, 0, 1); PG8_STAGE(PG8_SB(0, 0), b2, voffB);
            PG8_BAR; PG8_WAIT_L(0); PG8_MMA(0, 1, At, B1); PG8_BAR;
            PG8_LDA(At, 0, 1); PG8_STAGE(PG8_SA(0, 0), a2, voffA);
            PG8_BAR; PG8_WAIT_L(0); PG8_MMA(1, 0, At, B0); PG8_BAR; PG8_SCHED;
            PG8_STAGE(PG8_SB(0, 1), b2 + hstepB, voffB);
            PG8_WAIT_V(6); PG8_BAR; PG8_MMA(1, 1, At, B1); PG8_BAR;
            PG8_LDB(B0, 1, 0); PG8_SCHED; PG8_LDA(At, 1, 0); PG8_STAGE(PG8_SA(0, 1), a2 + hstepA, voffA);
            PG8_WAIT_L(8); PG8_BAR; PG8_WAIT_L(0); PG8_MMA(0, 0, At, B0); PG8_BAR; PG8_SCHED;
            PG8_LDB(B1, 1, 1); PG8_STAGE(PG8_SB(1, 0), b3, voffB);
            PG8_BAR; PG8_WAIT_L(0); PG8_MMA(0, 1, At, B1); PG8_BAR;
            PG8_LDA(At, 1, 1); PG8_STAGE(PG8_SA(1, 0), a3, voffA);
            PG8_BAR; PG8_WAIT_L(0); PG8_MMA(1, 0, At, B0); PG8_BAR; PG8_SCHED;
            PG8_STAGE(PG8_SB(1, 1), b3 + hstepB, voffB);
            PG8_WAIT_V(6); PG8_BAR; PG8_MMA(1, 1, At, B1); PG8_BAR;
        }
        if constexpr (FP8) asm volatile("s_nop 15\n\ts_nop 15" ::: "memory");
        if constexpr (FMT == 2) {
            const float w0 = *g.ws0, w1 = *g.ws1;
#pragma unroll
            for (int a = 0; a < 2; ++a)
#pragma unroll
                for (int m = 0; m < 4; ++m) { const float r = g.rs[(size_t)cur.pm * BM + a * HALF + wr * 64 + m * 16 + fr]; const float s0 = r * w0, s1 = r * w1;
#pragma unroll
                    for (int n = 0; n < 2; ++n)
#pragma unroll
                        for (int j = 0; j < 4; ++j) { acc[a][0][m][n][j] = (float)__float_as_int(acc[a][0][m][n][j]) * s0; acc[a][1][m][n][j] = (float)__float_as_int(acc[a][1][m][n][j]) * s1; } }
        }
        E(acc, cur, wr, wc, fr, fq);
        if (!has_next) break;
        bool keep = false; if constexpr (Epi::KEEP) keep = E.keep(cur);
        if (!keep)
#pragma unroll
        for (int a = 0; a < 2; ++a)
#pragma unroll
            for (int b = 0; b < 2; ++b)
#pragma unroll
                for (int m = 0; m < 4; ++m)
#pragma unroll
                    for (int n = 0; n < 2; ++n) acc[a][b][m][n] = (f32x4){0.f, 0.f, 0.f, 0.f};
        cur = nxt; cA = nA; cB = nB; ++ui;
    }
    PG8_WAIT_V(0);
    if (wr == 0) PG8_BAR;
    PG8_BAR;
#undef PG8_SA
#undef PG8_SB
#undef PG8_STAGE
#undef PG8_LDA
#undef PG8_LDB
#undef PG8_MMA
#undef PG8_WAIT_V
#undef PG8_WAIT_L
#undef PG8_BAR
#undef PG8_SCHED
}

#define EPI_LOOP_AM _Pragma("unroll") for (int ai = 0; ai < 2; ++ai) _Pragma("unroll") for (int m = 0; m < 4; ++m)
__device__ __forceinline__ f32x4 silu4(f32x4 v) { f32x4 o; _Pragma("unroll") for (int j = 0; j < 4; ++j) o[j] = v[j] * __builtin_amdgcn_rcpf(1.0f + __expf(-v[j])); return o; }
__device__ __forceinline__ f32x4 sigm4(f32x4 v) { f32x4 o; _Pragma("unroll") for (int j = 0; j < 4; ++j) o[j] = __builtin_amdgcn_rcpf(1.0f + __expf(-v[j])); return o; }
struct FEpiWinA {
    static constexpr bool PERM = true, KEEP = false;
    bf16_t* QM; float* LF; bf16_t* HI; bf16_t* HG; bf16_t* MU; bf16_t* MV; const float* lb; float sc;
    __device__ __forceinline__ void operator()(const f32x4 (&acc)[2][2][4][2], const Unit& u, int wr, int wc, int fr, int fq) const {
        const int row0 = u.pm * BM + wr * 64 + fr, grp = u.pn >> 1, cb = (u.pn & 1) * 256 + wc * 32 + 8 * fq;
        if (grp == 1) {
            f32x4 l0[2], l1[2];
#pragma unroll
            for (int bj = 0; bj < 2; ++bj) { l0[bj] = *(const f32x4*)(lb + cb + bj * HALF); l1[bj] = *(const f32x4*)(lb + cb + bj * HALF + 4); }
            EPI_LOOP_AM { float* rp = LF + (size_t)(row0 + ai * HALF + m * 16) * 512 + cb;
#pragma unroll
                for (int bj = 0; bj < 2; ++bj) { f32x4 o0, o1;
#pragma unroll
                    for (int j = 0; j < 4; ++j) { const float z0 = fmaxf(acc[ai][bj][m][0][j] * sc, -80.f), z1 = fmaxf(acc[ai][bj][m][1][j] * sc, -80.f);
                        o0[j] = __builtin_amdgcn_logf(l0[bj][j] + (1.f - l0[bj][j]) * __builtin_amdgcn_rcpf(1.0f + __expf(-z0))); o1[j] = __builtin_amdgcn_logf(l1[bj][j] + (1.f - l1[bj][j]) * __builtin_amdgcn_rcpf(1.0f + __expf(-z1))); }
                    __builtin_nontemporal_store(o0, (f32x4*)(rp + bj * HALF)); __builtin_nontemporal_store(o1, (f32x4*)(rp + bj * HALF + 4)); } }
        } else if (grp == 0 || grp == 6) {
            bf16_t* base = QM + (grp == 6 ? 512 : 0);
            EPI_LOOP_AM { bf16_t* rp = base + (size_t)(row0 + ai * HALF + m * 16) * 1024 + cb;
#pragma unroll
                for (int bj = 0; bj < 2; ++bj) { const f32x4 a = acc[ai][bj][m][0] * sc, b = acc[ai][bj][m][1] * sc;
                    __builtin_nontemporal_store((grp == 0) ? pack8(silu4(a), silu4(b)) : pack8(sigm4(a), sigm4(b)), (u32x4*)(rp + bj * HALF)); } }
        } else {
            bf16_t* base = (grp == 2) ? HI : (grp == 3) ? HG : (grp == 4) ? MU : MV;
            EPI_LOOP_AM { bf16_t* rp = base + (size_t)(row0 + ai * HALF + m * 16) * 512 + cb;
#pragma unroll
                for (int bj = 0; bj < 2; ++bj) { const f32x4 a = acc[ai][bj][m][0] * sc, b = acc[ai][bj][m][1] * sc;
                    __builtin_nontemporal_store((grp == 3) ? pack8(silu4(a), silu4(b)) : pack8(a, b), (u32x4*)(rp + bj * HALF)); } }
        }
    }
};
struct FEpiWinG {
    static constexpr bool PERM = true, KEEP = false;
    bf16_t* GA; bf16_t* GB; float sc;
    __device__ __forceinline__ void operator()(const f32x4 (&acc)[2][2][4][2], const Unit& u, int wr, int wc, int fr, int fq) const {
        const int row0 = u.pm * BM + wr * 64 + fr, cb = (u.pn & 7) * 128 + wc * 32 + 8 * fq;
        EPI_LOOP_AM { const size_t ro = (size_t)(row0 + ai * HALF + m * 16) * 1024 + cb; f32x4 ra[2], sb[2];
#pragma unroll
            for (int n = 0; n < 2; ++n)
#pragma unroll
                for (int j = 0; j < 4; ++j) { const float ea = __expf(-acc[ai][0][m][n][j] * sc), eb = __expf(-acc[ai][1][m][n][j] * sc); const float s = __builtin_amdgcn_rcpf(1.0f + eb); sb[n][j] = s; ra[n][j] = (1.0f + eb) * __builtin_amdgcn_rcpf(1.0f + ea); }
            __builtin_nontemporal_store(pack8(ra[0], ra[1]), (u32x4*)(GA + ro)); __builtin_nontemporal_store(pack8(sb[0], sb[1]), (u32x4*)(GB + ro)); }
    }
};
struct FEpiBrG {
    static constexpr bool PERM = true, KEEP = true;
    const bf16_t* RA; const bf16_t* SB; bf16_t* Mg; bool M8; float msc;
    __device__ __forceinline__ bool keep(const Unit& u) const { return u.pn < 8; }
    __device__ __forceinline__ void operator()(f32x4 (&acc)[2][2][4][2], const Unit& u, int wr, int wc, int fr, int fq) const {
        const bool first = u.pn < 8; const int row0 = u.pm * BM + wr * 64 + fr, cb = (u.pn & 7) * 256 + wc * 32 + 8 * fq; const bf16_t* Gp = first ? RA : SB;
        u32x4 gq[2][4][2];
#pragma unroll
        for (int ai = 0; ai < 2; ++ai)
#pragma unroll
            for (int m = 0; m < 4; ++m)
#pragma unroll
                for (int bj = 0; bj < 2; ++bj) gq[ai][m][bj] = *(const u32x4*)(Gp + (size_t)(row0 + ai * HALF + m * 16) * 1024 + cb + bj * HALF);
#pragma unroll
        for (int ai = 0; ai < 2; ++ai) {
#pragma unroll
            for (int m = 0; m < 4; ++m)
#pragma unroll
                for (int bj = 0; bj < 2; ++bj) { f32x4 g0, g1; unpack8(gq[ai][m][bj], g0, g1); acc[ai][bj][m][0] *= g0; acc[ai][bj][m][1] *= g1;
                    if (!first) {
                        if (M8) { const f32x4 a = acc[ai][bj][m][0] * msc, b = acc[ai][bj][m][1] * msc; unsigned q0 = 0u, q1 = 0u;
                            q0 = __builtin_amdgcn_cvt_pk_fp8_f32(sat8(a[0]), sat8(a[1]), q0, false); q0 = __builtin_amdgcn_cvt_pk_fp8_f32(sat8(a[2]), sat8(a[3]), q0, true);
                            q1 = __builtin_amdgcn_cvt_pk_fp8_f32(sat8(b[0]), sat8(b[1]), q1, false); q1 = __builtin_amdgcn_cvt_pk_fp8_f32(sat8(b[2]), sat8(b[3]), q1, true);
                            *(uint2*)((unsigned char*)Mg + (size_t)(row0 + ai * HALF + m * 16) * 1024 + cb + bj * HALF) = make_uint2(q0, q1); }
                        else __builtin_nontemporal_store(pack8(acc[ai][bj][m][0] * msc, acc[ai][bj][m][1] * msc), (u32x4*)(Mg + (size_t)(row0 + ai * HALF + m * 16) * 1024 + cb + bj * HALF)); } }
        }
    }
};
template <bool XIN_F32> struct FEpiResidT {
    static constexpr bool PERM = true, KEEP = false;
    const void* xin; bf16_t* xout; const float* mod; float sc;
    __device__ __forceinline__ void operator()(const f32x4 (&acc)[2][2][4][2], const Unit& u, int wr, int wc, int fr, int fq) const {
        const int row0 = u.pm * BM + wr * 64 + fr, cb = u.pn * BM + wc * 32 + 8 * fq;
        const float* gp = mod + (size_t)(u.pm >> 3) * 3072 + 2048 + cb;
        f32x4 gv[2][2];
#pragma unroll
        for (int bj = 0; bj < 2; ++bj)
#pragma unroll
            for (int n = 0; n < 2; ++n) gv[bj][n] = *(const f32x4*)(gp + bj * HALF + 4 * n) * sc;
#pragma unroll
        for (int ai = 0; ai < 2; ++ai) {
            f32x4 xv[4][2][2];
#pragma unroll
            for (int m = 0; m < 4; ++m)
#pragma unroll
                for (int bj = 0; bj < 2; ++bj) { const size_t ro = (size_t)(row0 + ai * HALF + m * 16) * 1024 + cb + bj * HALF;
                    if (XIN_F32) { xv[m][bj][0] = *(const f32x4*)((const float*)xin + ro); xv[m][bj][1] = *(const f32x4*)((const float*)xin + ro + 4); }
                    else unpack8(*(const u32x4*)((const bf16_t*)xin + ro), xv[m][bj][0], xv[m][bj][1]); }
#pragma unroll
            for (int m = 0; m < 4; ++m)
#pragma unroll
                for (int bj = 0; bj < 2; ++bj) { const size_t ro = (size_t)(row0 + ai * HALF + m * 16) * 1024 + cb + bj * HALF;
                    __builtin_nontemporal_store(pack8(xv[m][bj][0] + gv[bj][0] * acc[ai][bj][m][0], xv[m][bj][1] + gv[bj][1] * acc[ai][bj][m][1]), (u32x4*)(xout + ro)); }
        }
    }
};
template <bool OUT8> struct FEpiSwigluT {
    static constexpr bool PERM = true, KEEP = false;
    bf16_t* U; int ldu, nN; float sc; int padz;
    __device__ __forceinline__ void operator()(const f32x4 (&acc)[2][2][4][2], const Unit& u, int wr, int wc, int fr, int fq) const {
        const int row0 = u.pm * BM + wr * 64 + fr, pnl = u.pn % nN, cb = pnl * 128 + wc * 32 + 8 * fq;
        EPI_LOOP_AM { const f32x4 o0 = silu4(acc[ai][0][m][0] * sc) * (acc[ai][1][m][0] * sc), o1 = silu4(acc[ai][0][m][1] * sc) * (acc[ai][1][m][1] * sc);
            if (OUT8) { unsigned q0 = 0u, q1 = 0u; q0 = __builtin_amdgcn_cvt_pk_fp8_f32(sat8(o0[0]), sat8(o0[1]), q0, false); q0 = __builtin_amdgcn_cvt_pk_fp8_f32(sat8(o0[2]), sat8(o0[3]), q0, true);
                q1 = __builtin_amdgcn_cvt_pk_fp8_f32(sat8(o1[0]), sat8(o1[1]), q1, false); q1 = __builtin_amdgcn_cvt_pk_fp8_f32(sat8(o1[2]), sat8(o1[3]), q1, true);
                unsigned char* rp = (unsigned char*)U + (size_t)(row0 + ai * HALF + m * 16) * ldu + cb; *(uint2*)rp = make_uint2(q0, q1);
                if (padz && pnl == nN - 1) *(uint2*)(rp + 128) = make_uint2(0u, 0u); }
            else __builtin_nontemporal_store(pack8(o0, o1), (u32x4*)(U + (size_t)(row0 + ai * HALF + m * 16) * ldu + cb)); }
    }
};
typedef FEpiSwigluT<false> FEpiSwiglu;
struct FEpiStoreBf {
    static constexpr bool PERM = true, KEEP = false;
    bf16_t* O; int ldo, nN; float sc;
    __device__ __forceinline__ void operator()(const f32x4 (&acc)[2][2][4][2], const Unit& u, int wr, int wc, int fr, int fq) const {
        const int row0 = u.pm * BM + wr * 64 + fr, cb = (u.pn % nN) * 256 + wc * 32 + 8 * fq;
        EPI_LOOP_AM { bf16_t* rp = O + (size_t)(row0 + ai * HALF + m * 16) * ldo + cb;
#pragma unroll
            for (int bj = 0; bj < 2; ++bj) __builtin_nontemporal_store(pack8(acc[ai][bj][m][0] * sc, acc[ai][bj][m][1] * sc), (u32x4*)(rp + bj * HALF)); }
    }
};
}

struct CvtJob { const float* src; bf16_t* dst; long long src_bstride; int K, ncols, ldsrc, nb, dst_rows_per_batch, mode, tile0, f8, dst_ld, pad; };
static_assert(sizeof(CvtJob) == 64 && offsetof(CvtJob, K) == 24 && offsetof(CvtJob, tile0) == 48 && offsetof(CvtJob, dst_ld) == 56, "CvtJob layout is read word-wise from LDS");
constexpr int N_CVT = 16;
#ifndef DENSE_F8
#define DENSE_F8 0
#endif
#ifndef MOE_F8
#define MOE_F8 1
#endif
#ifndef MOED_F8
#define MOED_F8 1
#endif
constexpr int W2_F8 = 6; constexpr int KD8 = 1536;
static_assert(OFF_UE + (size_t)MOE_ROWS * (MOED_F8 ? (size_t)KD8 : (size_t)D_FFE * 2) <= OFF_XB && OFF_U + (size_t)TOK * D_FF * 2 <= OFF_XB, "FFN overlays must stay below the residual stream");
#ifndef DENSED_F8
#define DENSED_F8 1
#endif
#ifndef WIN1_F8
#define WIN1_F8 1
#endif
constexpr int W13_F8 = 5;
#ifndef BR_F8
#define BR_F8 1
#endif
constexpr int BR_A_SH = 4;
#ifndef OUT_F8
#define OUT_F8 1
#endif
constexpr int OUT_A_SH = 3;
#ifndef USE_I8
#define USE_I8 1
#endif
constexpr int N_I8J = 10;
__host__ __device__ constexpr int i8job(int i) { return i < 6 ? i : (i == 6 ? 9 : (i == 7 ? 10 : (i == 8 ? 12 : 13))); }
constexpr int I8_FLAG = 64;
constexpr float I8_CLIP = 4.0f;
constexpr size_t OFF_WSTEP = OFF_MISC + 9 * MiB;
constexpr size_t OFF_RSH = OFF_MISC + 9 * MiB + 4096;
constexpr size_t OFF_RSE = OFF_MISC + 10 * MiB;
struct CvtJobs { CvtJob j[N_CVT]; int total_tiles; int pad; };
typedef float vf4 __attribute__((ext_vector_type(4)));
constexpr int MT_PITCH = 132;
__device__ __forceinline__ void cvt_mt_load(const CvtJob& jb, int lt, int t, vf4 (&ld)[8]) {
    const int tk = jb.K / 64, tn = jb.ncols / 128, per_b = tk * tn, b = lt / per_b, r = lt % per_b, kt = r / tn, ntile = r % tn;
    const float* sp = jb.src + (size_t)b * jb.src_bstride + (size_t)(kt * 64) * jb.ldsrc + ntile * 128;
    const int r0 = t >> 5, c4 = (t & 31) * 4;
#pragma unroll
    for (int q = 0; q < 8; ++q) ld[q] = *(const vf4*)(sp + (size_t)(r0 + 8 * q) * jb.ldsrc + c4);
}
__device__ __forceinline__ void cvt_mt_lds(int t, const vf4 (&ld)[8], LAS3 float* tile) {
    const int r0 = t >> 5, c4 = (t & 31) * 4;
#pragma unroll
    for (int q = 0; q < 8; ++q) *(LAS3 vf4*)(tile + (r0 + 8 * q) * MT_PITCH + c4) = ld[q];
}
__device__ __forceinline__ void cvt_mt_store(const CvtJob& jb, int lt, int t, const LAS3 float* tile, const LAS3 float* wql) {
    const int tk = jb.K / 64, tn = jb.ncols / 128, per_b = tk * tn, b = lt / per_b, r = lt % per_b, kt = r / tn, ntile = r % tn;
    const int nl = t >> 1, kh = (t & 1) * 32, j = ntile * 128 + nl;
    const int drow = b * jb.dst_rows_per_batch + (jb.mode == 0 ? j : ((j >> 7) * 256 + (j & 127) + (jb.mode == 2 ? 128 : 0)));
    float v[32];
#pragma unroll
    for (int i = 0; i < 32; ++i) v[i] = tile[(kh + i) * MT_PITCH + nl];
    if (jb.f8 >= I8_FLAG) {
        const float qm = wql[jb.pad]; unsigned w[8];
#pragma unroll
        for (int i = 0; i < 8; ++i) w[i] = pack_i8x4(__builtin_amdgcn_fmed3f(v[4 * i] * qm, -127.0f, 127.0f), __builtin_amdgcn_fmed3f(v[4 * i + 1] * qm, -127.0f, 127.0f),
                                                      __builtin_amdgcn_fmed3f(v[4 * i + 2] * qm, -127.0f, 127.0f), __builtin_amdgcn_fmed3f(v[4 * i + 3] * qm, -127.0f, 127.0f));
        uint4* dp = (uint4*)((unsigned char*)jb.dst + (size_t)drow * jb.dst_ld + kt * 64 + kh);
        dp[0] = make_uint4(w[0], w[1], w[2], w[3]); dp[1] = make_uint4(w[4], w[5], w[6], w[7]);
        return; }
    if (jb.f8) {
        const float sc = (float)(1 << jb.f8); unsigned w[8];
#pragma unroll
        for (int i = 0; i < 8; ++i) { unsigned q = 0u;
            q = __builtin_amdgcn_cvt_pk_fp8_f32(sat8(v[4 * i] * sc), sat8(v[4 * i + 1] * sc), q, false);
            q = __builtin_amdgcn_cvt_pk_fp8_f32(sat8(v[4 * i + 2] * sc), sat8(v[4 * i + 3] * sc), q, true); w[i] = q; }
        uint4* dp = (uint4*)((unsigned char*)jb.dst + (size_t)drow * jb.dst_ld + kt * 64 + kh);
        dp[0] = make_uint4(w[0], w[1], w[2], w[3]); dp[1] = make_uint4(w[4], w[5], w[6], w[7]);
        return; }
    unsigned w[16];
#pragma unroll
    for (int i = 0; i < 16; ++i) w[i] = cvt2bf(v[2 * i], v[2 * i + 1]);
    uint4* dp = (uint4*)(jb.dst + (size_t)drow * jb.dst_ld + kt * 64 + kh);
#pragma unroll
    for (int i = 0; i < 4; ++i) dp[i] = make_uint4(w[4 * i], w[4 * i + 1], w[4 * i + 2], w[4 * i + 3]);
}
namespace sc {
typedef short bf16x8 __attribute__((ext_vector_type(8)));
typedef float f32x4 __attribute__((ext_vector_type(4)));
typedef unsigned u32x2 __attribute__((ext_vector_type(2)));
typedef unsigned u32x4v __attribute__((ext_vector_type(4)));
constexpr int PD = 136, PS = 72;
constexpr int SCAN_LDS = 128 * 1024;
DEVI f32x4 mma(bf16x8 x, bf16x8 y, f32x4 c) { return __builtin_amdgcn_mfma_f32_16x16x32_bf16(x, y, c, 0, 0, 0); }
DEVI bf16x8 ldf(const LAS3 bf16_t* base, int pitch, int row, int k0) { return *(const LAS3 bf16x8*)(base + row * pitch + k0); }
DEVI unsigned pk2(float lo, float hi) { return cvt2bf(lo, hi); }
DEVI void st4(LAS3 bf16_t* p, f32x4 v) { u32x2 w; w.x = pk2(v[0], v[1]); w.y = pk2(v[2], v[3]); *(LAS3 u32x2*)p = w; }
DEVI float clampe(float x) { return __builtin_amdgcn_fmed3f(x, -115.f, 115.f); }

DEVI void lds_barrier() { asm volatile("s_waitcnt lgkmcnt(0)" ::: "memory"); __builtin_amdgcn_s_barrier(); asm volatile("" ::: "memory"); }
#define SC_FENCE() __builtin_amdgcn_sched_barrier(0)
DEVI void hgrn2_item(LAS3 unsigned char* L, int b, int h, const bf16_t* QM, bf16_t* YO, const float* __restrict__ LF, const bf16_t* __restrict__ HI, const bf16_t* __restrict__ HG, const float* __restrict__ gnorm) {
    LAS3 bf16_t* Qt = (LAS3 bf16_t*)L;
    LAS3 bf16_t* Kt = Qt + 64 * PD;
    LAS3 bf16_t* KtT = Kt + 64 * PD;
    LAS3 bf16_t* VT = KtT + 128 * PS;
    LAS3 bf16_t* Pm = VT + 128 * PS;
    LAS3 bf16_t* ST = Pm + 64 * PS;
    LAS3 float* er = (LAS3 float*)(ST + 128 * PD);
    LAS3 float* ea = er + 128;
    LAS3 float* segs = ea + 128;
    LAS3 float* red = segs + 512;
    LAS3 float* gnl = red + 128;
    const int tid = tid_(), wid = __builtin_amdgcn_readfirstlane(tid >> 6), lane = tid & 63, fr = lane & 15, fq = lane >> 4;
    const int ch = tid & 127, sg = tid >> 7;
    const int tj = wid & 3, hw = wid >> 2;
    f32x4 S[8];
#pragma unroll
    for (int i = 0; i < 8; ++i) S[i] = (f32x4){0.f, 0.f, 0.f, 0.f};
    if (tid < 128) gnl[tid] = gnorm[h * 128 + tid];
    float lfv[16]; bf16_t qv[16], vv[16];
#define HG_LOAD(cc) do { const size_t r0_ = (size_t)b * SEQL + (size_t)(cc) * 64; \
        const float* lp = LF + (r0_ + 16 * sg) * 512 + h * 128 + ch; const bf16_t* qp = QM + (r0_ + 16 * sg) * 1024 + h * 128 + ch; const bf16_t* vp = HI + (r0_ + 16 * sg) * 512 + h * 128 + ch; \
        _Pragma("unroll") for (int i = 0; i < 16; ++i) { lfv[i] = lp[(size_t)i * 512]; qv[i] = qp[(size_t)i * 1024]; vv[i] = vp[(size_t)i * 512]; } } while (0)
    HG_LOAD(0);
    for (int c = 0; c < SEQL / 64; ++c) {
        const size_t row0 = (size_t)b * SEQL + (size_t)c * 64;
        float a[16]; uint2 hgv[4];
        { float run = 0.f;
#pragma unroll
          for (int i = 0; i < 16; ++i) { run += lfv[i]; a[i] = run; }
          segs[sg * 128 + ch] = run; }
#pragma unroll
        for (int q = 0; q < 4; ++q) hgv[q] = *(const uint2*)(HG + (row0 + 16 * tj + fr) * 512 + h * 128 + 16 * (4 * hw + q) + 4 * fq);
        lds_barrier();
        { const float s0 = segs[ch], s1 = segs[128 + ch], s2 = segs[256 + ch], s3 = segs[384 + ch];
          const float off = (sg > 0 ? s0 : 0.f) + (sg > 1 ? s1 : 0.f) + (sg > 2 ? s2 : 0.f), r = s0 + s1, alast = (s0 + s1) + (s2 + s3);
          if (sg == 0) { er[ch] = __builtin_amdgcn_exp2f(fmaxf(r, -115.f)); ea[ch] = __builtin_amdgcn_exp2f(fmaxf(alast - r, -115.f)); }
          unsigned kw[8], vw[8];
#pragma unroll
          for (int i = 0; i < 16; i += 2) {
              const float A0 = off + a[i], A1 = off + a[i + 1];
              const float e0 = __builtin_amdgcn_exp2f(clampe(A0 - r)), e1 = __builtin_amdgcn_exp2f(clampe(A1 - r));
              const float q0 = bf2f(qv[i]) * e0, q1 = bf2f(qv[i + 1]) * e1;
              const float kk0 = 1.0f - __builtin_amdgcn_exp2f(lfv[i]), kk1 = 1.0f - __builtin_amdgcn_exp2f(lfv[i + 1]);
              const float k0 = kk0 * __builtin_amdgcn_rcpf(e0), k1 = kk1 * __builtin_amdgcn_rcpf(e1);
              const unsigned kp = pk2(k0, k1);
              Qt[(16 * sg + i) * PD + ch] = f2bf(q0); Qt[(16 * sg + i + 1) * PD + ch] = f2bf(q1);
              Kt[(16 * sg + i) * PD + ch] = (bf16_t)(kp & 0xffffu); Kt[(16 * sg + i + 1) * PD + ch] = (bf16_t)(kp >> 16);
              kw[i >> 1] = kp; vw[i >> 1] = (unsigned)vv[i] | ((unsigned)vv[i + 1] << 16);
          }
          *(LAS3 u32x4v*)(KtT + ch * PS + 16 * sg) = (u32x4v){kw[0], kw[1], kw[2], kw[3]}; *(LAS3 u32x4v*)(KtT + ch * PS + 16 * sg + 8) = (u32x4v){kw[4], kw[5], kw[6], kw[7]};
          *(LAS3 u32x4v*)(VT + ch * PS + 16 * sg) = (u32x4v){vw[0], vw[1], vw[2], vw[3]}; *(LAS3 u32x4v*)(VT + ch * PS + 16 * sg + 8) = (u32x4v){vw[4], vw[5], vw[6], vw[7]}; }
        if (c + 1 < SEQL / 64) HG_LOAD(c + 1);
        lds_barrier();
        { const f32x4 erv = *(const LAS3 f32x4*)(er + 16 * wid + 4 * fq);
#pragma unroll
          for (int vt = 0; vt < 8; ++vt) { S[vt] *= erv; st4(ST + (16 * vt + fr) * PD + 16 * wid + 4 * fq, S[vt]); } }
        { const int ti = wid >> 1; bf16x8 yq1[4], xk1[2][4];
#pragma unroll
          for (int k4 = 0; k4 < 4; ++k4) yq1[k4] = ldf(Qt, PD, 16 * ti + fr, 32 * k4 + 8 * fq);
#pragma unroll
          for (int q2 = 0; q2 < 2; ++q2)
#pragma unroll
              for (int k4 = 0; k4 < 4; ++k4) xk1[q2][k4] = ldf(Kt, PD, 16 * (2 * (wid & 1) + q2) + fr, 32 * k4 + 8 * fq);
          SC_FENCE();
#pragma unroll
          for (int q2 = 0; q2 < 2; ++q2) { const int si = 2 * (wid & 1) + q2; f32x4 acc = (f32x4){0.f, 0.f, 0.f, 0.f};
#pragma unroll
              for (int k4 = 0; k4 < 4; ++k4) acc = mma(xk1[q2][k4], yq1[k4], acc);
              const int t = 16 * ti + fr, s0 = 16 * si + 4 * fq;
#pragma unroll
              for (int j = 0; j < 4; ++j) acc[j] = (s0 + j <= t) ? acc[j] : 0.f;
              st4(Pm + t * PS + s0, acc); } }
        lds_barrier();
        f32x4 O[4];
        { bf16x8 yp[2], yq[4], xv[2][6];
#pragma unroll
          for (int k2 = 0; k2 < 2; ++k2) yp[k2] = ldf(Pm, PS, 16 * tj + fr, 32 * k2 + 8 * fq);
#pragma unroll
          for (int k4 = 0; k4 < 4; ++k4) yq[k4] = ldf(Qt, PD, 16 * tj + fr, 32 * k4 + 8 * fq);
#define HG_LDX(buf, q_) do { const int vi_ = 4 * hw + (q_); _Pragma("unroll") for (int k2 = 0; k2 < 2; ++k2) xv[buf][k2] = ldf(VT, PS, 16 * vi_ + fr, 32 * k2 + 8 * fq); \
              _Pragma("unroll") for (int k4 = 0; k4 < 4; ++k4) xv[buf][2 + k4] = ldf(ST, PD, 16 * vi_ + fr, 32 * k4 + 8 * fq); } while (0)
          HG_LDX(0, 0);
#pragma unroll
          for (int q = 0; q < 4; ++q) { if (q + 1 < 4) HG_LDX((q + 1) & 1, q + 1);
              SC_FENCE();
              f32x4 acc = (f32x4){0.f, 0.f, 0.f, 0.f};
#pragma unroll
              for (int k2 = 0; k2 < 2; ++k2) acc = mma(xv[q & 1][k2], yp[k2], acc);
#pragma unroll
              for (int k4 = 0; k4 < 4; ++k4) acc = mma(xv[q & 1][2 + k4], yq[k4], acc);
              O[q] = acc; SC_FENCE(); }
#undef HG_LDX
        }
        { float ss = 0.f;
#pragma unroll
          for (int q = 0; q < 4; ++q) ss += O[q][0] * O[q][0] + O[q][1] * O[q][1] + O[q][2] * O[q][2] + O[q][3] * O[q][3];
          ss += __shfl_xor(ss, 16); ss += __shfl_xor(ss, 32);
          if (fq == 0) red[hw * 64 + 16 * tj + fr] = ss; }
        { bf16x8 xk[2], yv[2][8];
#pragma unroll
          for (int k2 = 0; k2 < 2; ++k2) xk[k2] = ldf(KtT, PS, 16 * wid + fr, 32 * k2 + 8 * fq);
          const f32x4 eav = *(const LAS3 f32x4*)(ea + 16 * wid + 4 * fq);
#define HG_LDV(buf, v0_) do { _Pragma("unroll") for (int i = 0; i < 4; ++i) _Pragma("unroll") for (int k2 = 0; k2 < 2; ++k2) yv[buf][2 * i + k2] = ldf(VT, PS, 16 * ((v0_) + i) + fr, 32 * k2 + 8 * fq); } while (0)
          HG_LDV(0, 0);
#pragma unroll
          for (int hf = 0; hf < 2; ++hf) { if (hf == 0) HG_LDV(1, 4);
              SC_FENCE();
#pragma unroll
              for (int i = 0; i < 4; ++i) { const int vt = 4 * hf + i;
#pragma unroll
                  for (int k2 = 0; k2 < 2; ++k2) S[vt] = mma(xk[k2], yv[hf][2 * i + k2], S[vt]);
                  S[vt] *= eav; }
              SC_FENCE(); }
#undef HG_LDV
        }
        lds_barrier();
        f32x4 gnr[4];
#pragma unroll
        for (int q = 0; q < 4; ++q) gnr[q] = *(const LAS3 f32x4*)(gnl + 16 * (4 * hw + q) + 4 * fq);
        { const float tot = red[16 * tj + fr] + red[64 + 16 * tj + fr]; const float rstd = rsqrtf(tot * (1.0f / 128.0f) + EPS);
          bf16_t* yp = YO + (row0 + 16 * tj + fr) * 1024 + h * 128 + 4 * fq;
          unsigned char* yp8 = (unsigned char*)(YO + (row0 + 16 * tj + fr) * 1024 + h * 128) + 4 * fq;
#pragma unroll
          for (int q = 0; q < 4; ++q) { f32x4 g;
              g[0] = __uint_as_float(hgv[q].x << 16); g[1] = __uint_as_float(hgv[q].x & 0xffff0000u); g[2] = __uint_as_float(hgv[q].y << 16); g[3] = __uint_as_float(hgv[q].y & 0xffff0000u);
              const f32x4 y = O[q] * rstd * gnr[q] * g;
              if (BR_F8) { const f32x4 ys = y * (float)(1 << BR_A_SH); unsigned q8 = 0u; q8 = __builtin_amdgcn_cvt_pk_fp8_f32(sat8(ys[0]), sat8(ys[1]), q8, false); q8 = __builtin_amdgcn_cvt_pk_fp8_f32(sat8(ys[2]), sat8(ys[3]), q8, true);
                  *(unsigned*)(yp8 + 16 * (4 * hw + q)) = q8; }
              else { uint2 w; w.x = pk2(y[0], y[1]); w.y = pk2(y[2], y[3]);
              *(uint2*)(yp + 16 * (4 * hw + q)) = w; } } }
    }
}
#undef HG_LOAD

DEVI void mlstm_item(LAS3 unsigned char* L, int b, int h, const bf16_t* QM, bf16_t* YO, const bf16_t* __restrict__ MU, const bf16_t* __restrict__ MV, const float* __restrict__ GATES,
                     const float* __restrict__ cw, const float* __restrict__ cb, const float* __restrict__ wq, const float* __restrict__ wk, float fb, const float* __restrict__ gnorm, unsigned* dbg) {
    (void)dbg;
    LAS3 bf16_t* UCt = (LAS3 bf16_t*)L;
    LAS3 bf16_t* WqT = UCt + 64 * PD;
    LAS3 bf16_t* WkT = WqT + 64 * PD;
    LAS3 bf16_t* Qm = WkT + 64 * PD;
    LAS3 bf16_t* Km = Qm + 64 * PS;
    LAS3 bf16_t* KwT = Km + 64 * PS;
    LAS3 bf16_t* VT = KwT + 64 * PS;
    LAS3 bf16_t* CT = VT + 144 * PS;
    LAS3 float* gvec = (LAS3 float*)(CT + 144 * PS);
    LAS3 float* Mvec = gvec + 64;
    LAS3 float* wint = Mvec + 64;
    LAS3 float* wsv = wint + 64;
    LAS3 float* emt = wsv + 64;
    LAS3 float* red = emt + 64;
    LAS3 float* scal = red + 128;
    LAS3 float* gnl = scal + 4;
    LAS3 bf16_t* Pm = UCt;
    const int tid = tid_(), wid = __builtin_amdgcn_readfirstlane(tid >> 6), lane = tid & 63, fr = lane & 15, fq = lane >> 4;
    const int ch = tid & 127, sg = tid >> 7;
    const int tj = wid & 3, hw = wid >> 2;
    for (int i = tid; i < 128 * 64; i += 512) { const int d = i >> 6, e = i & 63; WqT[e * PD + d] = f2bf(0.125f * wq[i]); WkT[e * PD + d] = f2bf(wk[i]); }
    for (int i = tid; i < 144 * PS; i += 512) { CT[i] = 0; if (i >= 128 * PS) VT[i] = (i < 129 * PS) ? (bf16_t)0x3F80 : (bf16_t)0; }
    f32x4 Cst[5];
#pragma unroll
    for (int i = 0; i < 5; ++i) Cst[i] = (f32x4){0.f, 0.f, 0.f, 0.f};
    const float cw0 = cw[ch + h * 128], cw1 = cw[512 + ch + h * 128], cw2 = cw[1024 + ch + h * 128], cw3 = cw[1536 + ch + h * 128], cbv = cb[ch + h * 128];
    float m_prev = 0.f;
    if (tid < 128) gnl[tid] = gnorm[h * 128 + tid];
    __syncthreads();
    bf16_t mur[19], vv[16]; float gin = 0.f, gfn = 0.f;
#define ML_LOAD(cc) do { const size_t r0_ = (size_t)b * SEQL + (size_t)(cc) * 64; \
        const bf16_t* mp = MU + (r0_ + 16 * sg) * 512 + h * 128 + ch; const bf16_t* vp = MV + (r0_ + 16 * sg) * 512 + h * 128 + ch; \
        _Pragma("unroll") for (int i = 0; i < 19; ++i) { const int tl = 64 * (cc) + 16 * sg + i - 3; mur[i] = (tl >= 0) ? mp[((long)i - 3) * 512] : (bf16_t)0; } \
        _Pragma("unroll") for (int i = 0; i < 16; ++i) vv[i] = vp[(size_t)i * 512]; \
        if (wid == 0) { gin = GATES[(r0_ + lane) * 8 + h]; gfn = GATES[(r0_ + lane) * 8 + 4 + h]; } } while (0)
    ML_LOAD(0);
    for (int c = 0; c < SEQL / 64; ++c) {
        const size_t row0 = (size_t)b * SEQL + (size_t)c * 64;
        { float mu[19];
#pragma unroll
          for (int i = 0; i < 19; ++i) mu[i] = bf2f(mur[i]);
#pragma unroll
          for (int i = 0; i < 16; ++i) { const float y = cbv + cw0 * mu[i] + cw1 * mu[i + 1] + cw2 * mu[i + 2] + cw3 * mu[i + 3]; UCt[(16 * sg + i) * PD + ch] = f2bf(y * __builtin_amdgcn_rcpf(1.0f + __expf(-y))); }
          unsigned vw[8];
#pragma unroll
          for (int i = 0; i < 8; ++i) vw[i] = (unsigned)vv[2 * i] | ((unsigned)vv[2 * i + 1] << 16);
          *(LAS3 u32x4v*)(VT + ch * PS + 16 * sg) = (u32x4v){vw[0], vw[1], vw[2], vw[3]}; *(LAS3 u32x4v*)(VT + ch * PS + 16 * sg + 8) = (u32x4v){vw[4], vw[5], vw[6], vw[7]}; }
        uint2 mov[4];
#pragma unroll
        for (int q = 0; q < 4; ++q) mov[q] = *(const uint2*)(QM + (row0 + 16 * tj + fr) * 1024 + 512 + h * 128 + 16 * (4 * hw + q) + 4 * fq);
        const float gmi = gin, gmf = gfn;
        if (c + 1 < SEQL / 64) ML_LOAD(c + 1);
        if (wid == 0) {
            const float mi = gmi, z = gmf + fb;
            const float lf = fminf(z, 0.f) - log1pf(__expf(-fabsf(z)));
            const float bsum = wave_scan_sum(lf);
            const float g = mi - bsum; const float cm = wave_scan_max(g);
            const float M = fmaxf(m_prev, cm);
            const float M63 = lane63(M), b63 = lane63(bsum);
            gvec[lane] = g; Mvec[lane] = M; wint[lane] = __expf(m_prev - M); wsv[lane] = __expf(g - M63); emt[lane] = __expf(-(bsum + M));
            if (lane == 0) scal[0] = __expf(m_prev - M63);
            m_prev = b63 + M63;
        }
        lds_barrier();
        { bf16x8 yu[4], xw[2][8];
#pragma unroll
          for (int k4 = 0; k4 < 4; ++k4) yu[k4] = ldf(UCt, PD, 16 * tj + fr, 32 * k4 + 8 * fq);
#define ML_LDW(buf, q2_) do { const int ei_ = 2 * hw + (q2_); _Pragma("unroll") for (int k4 = 0; k4 < 4; ++k4) { xw[buf][k4] = ldf(WqT, PD, 16 * ei_ + fr, 32 * k4 + 8 * fq); xw[buf][4 + k4] = ldf(WkT, PD, 16 * ei_ + fr, 32 * k4 + 8 * fq); } } while (0)
          ML_LDW(0, 0);
#pragma unroll
          for (int q2 = 0; q2 < 2; ++q2) { const int ei = 2 * hw + q2; f32x4 aq = (f32x4){0.f, 0.f, 0.f, 0.f}, ak = aq, akt = aq;
              if (q2 == 0) ML_LDW(1, 1);
              SC_FENCE();
#pragma unroll
              for (int k4 = 0; k4 < 4; ++k4) { aq = mma(xw[q2][k4], yu[k4], aq); ak = mma(xw[q2][4 + k4], yu[k4], ak); akt = mma(yu[k4], xw[q2][4 + k4], akt); }
              SC_FENCE();
              st4(Qm + (16 * tj + fr) * PS + 16 * ei + 4 * fq, aq); st4(Km + (16 * tj + fr) * PS + 16 * ei + 4 * fq, ak);
              const f32x4 wv = *(const LAS3 f32x4*)(wsv + 16 * tj + 4 * fq);
              st4(KwT + (16 * ei + fr) * PS + 16 * tj + 4 * fq, akt * wv); }
#undef ML_LDW
        }
        lds_barrier();
        { const int ti = wid >> 1; const float Mt = Mvec[16 * ti + fr]; bf16x8 yq2[2], xk2[2][2];
#pragma unroll
          for (int k2 = 0; k2 < 2; ++k2) yq2[k2] = ldf(Qm, PS, 16 * ti + fr, 32 * k2 + 8 * fq);
#pragma unroll
          for (int q2 = 0; q2 < 2; ++q2)
#pragma unroll
              for (int k2 = 0; k2 < 2; ++k2) xk2[q2][k2] = ldf(Km, PS, 16 * (2 * (wid & 1) + q2) + fr, 32 * k2 + 8 * fq);
          SC_FENCE();
#pragma unroll
          for (int q2 = 0; q2 < 2; ++q2) { const int si = 2 * (wid & 1) + q2; f32x4 acc = (f32x4){0.f, 0.f, 0.f, 0.f};
#pragma unroll
              for (int k2 = 0; k2 < 2; ++k2) acc = mma(xk2[q2][k2], yq2[k2], acc);
              const int t = 16 * ti + fr, s0 = 16 * si + 4 * fq; const f32x4 gv = *(const LAS3 f32x4*)(gvec + s0);
#pragma unroll
              for (int j = 0; j < 4; ++j) acc[j] = (s0 + j <= t) ? acc[j] * __expf(gv[j] - Mt) : 0.f;
              st4(Pm + t * PS + s0, acc); } }
        lds_barrier();
        f32x4 O[4]; float den;
        { bf16x8 yq[2], yp[2], xk[2], vt[5][2], ct[2][2];
#pragma unroll
          for (int k2 = 0; k2 < 2; ++k2) { yq[k2] = ldf(Qm, PS, 16 * tj + fr, 32 * k2 + 8 * fq); yp[k2] = ldf(Pm, PS, 16 * tj + fr, 32 * k2 + 8 * fq); }
#define ML_VI(q_) (((q_) < 4) ? 4 * hw + (q_) : 8)
#pragma unroll
          for (int k2 = 0; k2 < 2; ++k2) ct[0][k2] = ldf(CT, PS, 16 * ML_VI(0) + fr, 32 * k2 + 8 * fq);
#pragma unroll
          for (int q = 0; q < 5; ++q)
#pragma unroll
              for (int k2 = 0; k2 < 2; ++k2) vt[q][k2] = ldf(VT, PS, 16 * ML_VI(q) + fr, 32 * k2 + 8 * fq);
#pragma unroll
          for (int k2 = 0; k2 < 2; ++k2) xk[k2] = ldf(KwT, PS, 16 * tj + fr, 32 * k2 + 8 * fq);
          const float wi = wint[16 * tj + fr];
          const float dp = scal[0];
#pragma unroll
          for (int q = 0; q < 5; ++q) { f32x4 acc = (f32x4){0.f, 0.f, 0.f, 0.f};
              if (q < 4) {
#pragma unroll
                  for (int k2 = 0; k2 < 2; ++k2) ct[(q + 1) & 1][k2] = ldf(CT, PS, 16 * ML_VI(q + 1) + fr, 32 * k2 + 8 * fq); }
              SC_FENCE();
#pragma unroll
              for (int k2 = 0; k2 < 2; ++k2) acc = mma(ct[q & 1][k2], yq[k2], acc);
              acc *= wi;
#pragma unroll
              for (int k2 = 0; k2 < 2; ++k2) acc = mma(vt[q][k2], yp[k2], acc);
              SC_FENCE();
              if (q < 4) O[q] = acc; else den = __shfl(acc[0], fr); }
          const float dn = __builtin_amdgcn_rcpf(fmaxf(fabsf(den), emt[16 * tj + fr])); float ss = 0.f;
#pragma unroll
          for (int q = 0; q < 4; ++q) { O[q] *= dn; ss += O[q][0] * O[q][0] + O[q][1] * O[q][1] + O[q][2] * O[q][2] + O[q][3] * O[q][3]; }
          ss += __shfl_xor(ss, 16); ss += __shfl_xor(ss, 32);
          if (fq == 0) red[hw * 64 + 16 * tj + fr] = ss;
#pragma unroll
          for (int q = 0; q < 5; ++q) { if (q == 4 && hw != 0) break; Cst[q] *= dp;
#pragma unroll
              for (int k2 = 0; k2 < 2; ++k2) Cst[q] = mma(xk[k2], vt[q][k2], Cst[q]); }
#undef ML_VI
        }
        lds_barrier();
        f32x4 gnr[4];
#pragma unroll
        for (int q = 0; q < 4; ++q) gnr[q] = *(const LAS3 f32x4*)(gnl + 16 * (4 * hw + q) + 4 * fq);
        { const float tot = red[16 * tj + fr] + red[64 + 16 * tj + fr]; const float rstd = rsqrtf(tot * (1.0f / 128.0f) + EPS);
          bf16_t* yp = YO + (row0 + 16 * tj + fr) * 1024 + 512 + h * 128 + 4 * fq;
          unsigned char* yp8 = (unsigned char*)(YO + (row0 + 16 * tj + fr) * 1024 + 512 + h * 128) + 4 * fq;
#pragma unroll
          for (int q = 0; q < 4; ++q) { f32x4 g;
              g[0] = __uint_as_float(mov[q].x << 16); g[1] = __uint_as_float(mov[q].x & 0xffff0000u); g[2] = __uint_as_float(mov[q].y << 16); g[3] = __uint_as_float(mov[q].y & 0xffff0000u);
              const f32x4 y = O[q] * rstd * gnr[q] * g;
              if (BR_F8) { const f32x4 ys = y * (float)(1 << BR_A_SH); unsigned q8 = 0u; q8 = __builtin_amdgcn_cvt_pk_fp8_f32(sat8(ys[0]), sat8(ys[1]), q8, false); q8 = __builtin_amdgcn_cvt_pk_fp8_f32(sat8(ys[2]), sat8(ys[3]), q8, true);
                  *(unsigned*)(yp8 + 16 * (4 * hw + q)) = q8; }
              else { uint2 w; w.x = pk2(y[0], y[1]); w.y = pk2(y[2], y[3]);
              *(uint2*)(yp + 16 * (4 * hw + q)) = w; } }
#pragma unroll
          for (int q = 0; q < 5; ++q) { if (q == 4 && hw != 0) break; const int vi = (q < 4) ? 4 * hw + q : 8; st4(CT + (16 * vi + fr) * PS + 16 * tj + 4 * fq, Cst[q]); } }
    }
}
#undef ML_LOAD
struct ScanArgs { const bf16_t* QM; bf16_t* YO; const float* LF; const bf16_t* HI; const bf16_t* HG; const bf16_t* MU; const bf16_t* MV; const float* GATES;
                  const float* hg_norm_g; const float* ml_norm_g; const float* conv_w; const float* conv_b; const float* wq; const float* wk; const float* fbias; unsigned* dbg; };
DEVI void scan_item(LAS3 unsigned char* L, const ScanArgs& a, int item) {
    const int bh = item & 127, b = bh >> 2, h = bh & 3;
    if (item < 128) hgrn2_item(L, b, h, a.QM, a.YO, a.LF, a.HI, a.HG, a.hg_norm_g);
    else mlstm_item(L, b, h, a.QM, a.YO, a.MU, a.MV, a.GATES, a.conv_w, a.conv_b, a.wq + (size_t)h * 128 * 64, a.wk + (size_t)h * 128 * 64, a.fbias[h], a.ml_norm_g, a.dbg);
}
}
constexpr size_t WT_IN = 0;
constexpr size_t WT_BRH = WT_IN + 2ull * 5632 * 1024;
constexpr size_t WT_BRM = WT_BRH + 2ull * 1024 * 512;
constexpr size_t WT_OUT = WT_BRM + 2ull * 1024 * 512;
constexpr size_t WT_F13 = WT_OUT + 2ull * 1024 * 1024;
constexpr size_t WT_F2 = WT_F13 + 5632ull * 1024;
constexpr size_t WT_M13 = WT_F2 + 1024ull * 2816;
constexpr size_t WT_M2 = WT_M13 + 8ull * 2816 * 1024;
constexpr size_t WT_END = WT_M2 + 8ull * 1024 * 1408;
static_assert(WT_END * 2 <= 120 * MiB, "weights region");


#define XB_TMO      128
#define XB_XCNT(j)  (256  + 64 * (j))
#define XB_XSUB(j)  (1280 + 64 * (j))
#define XB_XGEN(j)  (2304 + 64 * (j))
#define XB_TOP      3328
#define XB_TOPGEN   3392
#define XCD_BAR_WORDS 3456
#define XB_SPIN_CAP (1u << 18)
#define LAS __attribute__((address_space(3)))
__device__ __forceinline__ unsigned xb_ld(unsigned* p)              { return __hip_atomic_load(p, __ATOMIC_RELAXED, __HIP_MEMORY_SCOPE_AGENT); }
__device__ __forceinline__ unsigned xb_add(unsigned* p, unsigned v) { return __hip_atomic_fetch_add(p, v, __ATOMIC_RELAXED, __HIP_MEMORY_SCOPE_AGENT); }
__device__ __forceinline__ unsigned xb_xcc_id() { return (unsigned)__builtin_amdgcn_s_getreg((3 << 11) | 20) & 0xFu; }
#define XB_SPIN(cond, bar) do { unsigned _sp = 0; while (cond) { __builtin_amdgcn_s_sleep(1); \
    if ((++_sp & 255u) == 0u) { if (xb_ld(&(bar)[XB_TMO])) break; if (_sp > XB_SPIN_CAP) { atomicAdd(&(bar)[XB_TMO], 1u); break; } } } } while (0)
struct XcdBarrier { unsigned* bar; unsigned x; volatile LAS unsigned* st; };
__device__ __forceinline__ XcdBarrier xcd_barrier_post(unsigned* bar, volatile LAS unsigned* st) {
    XcdBarrier b; b.bar = bar; b.x = xb_xcc_id(); b.st = st;
    if (tid_() == 0) (void)xb_add(&bar[XB_XCNT(b.x)], 1u);
    return b;
}
__device__ __forceinline__ void xcd_barrier_complete(unsigned* bar, unsigned x, unsigned& nloc, unsigned& nx) {
    const unsigned G = gridDim.x * gridDim.y * gridDim.z;
    unsigned sum, cnt, mine, sp = 0u;
    for (;;) {
        sum = 0u; cnt = 0u; mine = 0u;
#pragma unroll
        for (unsigned j = 0; j < 16; ++j) { const unsigned c = xb_ld(&bar[XB_XCNT(j)]); sum += c; cnt += (c > 0u) ? 1u : 0u; mine = (j == x) ? c : mine; }
        if (sum == G) break;
        __builtin_amdgcn_s_sleep(1);
        if ((++sp & 255u) == 0u) { if (xb_ld(&bar[XB_TMO])) break; if (sp > XB_SPIN_CAP) { atomicAdd(&bar[XB_TMO], 1u); break; } }
    }
    nloc = mine > 0u ? mine : 1u; nx = cnt > 0u ? cnt : 1u;
}
__device__ __forceinline__ void xcd_barrier(const XcdBarrier& b) {
    asm volatile("s_waitcnt vmcnt(0)" ::: "memory");
    __syncthreads();
    if (tid_() == 0) {
        unsigned* bar = b.bar;
        __builtin_amdgcn_s_waitcnt(0);
        unsigned nloc = b.st[0], nx = b.st[1];
        if (nloc == 0u) { xcd_barrier_complete(bar, b.x, nloc, nx); b.st[0] = nloc; b.st[1] = nx; }
        const unsigned old = xb_add(&bar[XB_XSUB(b.x)], 1u);
        const unsigned gen = old / nloc;
        if (old + 1u == (gen + 1u) * nloc) {
            __builtin_amdgcn_fence(__ATOMIC_RELEASE, "agent");
            asm volatile("s_waitcnt vmcnt(0)" ::: "memory");
            const unsigned og = xb_add(&bar[XB_TOP], 1u);
            const unsigned tg = og / nx;
            if (og + 1u == (tg + 1u) * nx) xb_add(&bar[XB_TOPGEN], 1u);
            else XB_SPIN(xb_ld(&bar[XB_TOPGEN]) == tg, bar);
            __builtin_amdgcn_fence(__ATOMIC_ACQUIRE, "agent");
            xb_add(&bar[XB_XGEN(b.x)], 1u);
            asm volatile("s_waitcnt vmcnt(0)" ::: "memory");
        } else {
            XB_SPIN(xb_ld(&bar[XB_XGEN(b.x)]) == gen, bar);
            __builtin_amdgcn_fence(__ATOMIC_ACQUIRE, "agent");
            asm volatile("s_waitcnt vmcnt(0)" ::: "memory");
        }
    }
    __syncthreads();
}

enum { I_X = 0, I_C, I_NORM_MIX_G, I_ADA_MIX_W, I_ADA_MIX_B, I_W_IN, I_LB, I_HG_NORM, I_CONV_W, I_CONV_B, I_WQ, I_WK, I_FBIAS, I_ML_NORM, I_BRH, I_BRM, I_WOUT,
       I_NORM_FFN_G, I_ADA_FFN_W, I_ADA_FFN_B, I_FW1, I_FW3, I_FW2, I_RW, I_RB, I_MW1, I_MW3, I_MW2, I_FINAL_G, N_IN };
struct Params { const float* in[N_IN]; float* out; unsigned char* ws; CvtJobs J; };
constexpr size_t OFF_BAR = OFF_MISC + 16 * 1024;
constexpr size_t OFF_CTR = OFF_MISC + 12 * 1024;
constexpr size_t OFF_MOECNT = OFF_CTR + 1024;
constexpr size_t OFF_LBT = OFF_MISC + 4096;
constexpr int LDS_BYTES = 128 * 1024 + 1024;
constexpr int LDSCTL = 128 * 1024;

DEVI void ada_unit(const Params& p, int unit, LAS3 unsigned char* lds, float* __restrict__ mod) {
    const int tid = tid_(), lane = tid & 63, kg = tid >> 6;
    const int s = unit / 48, jc = unit % 48, l = s >> 1, sub = s & 1;
    const float* W = (sub ? p.in[I_ADA_FFN_W] : p.in[I_ADA_MIX_W]) + (size_t)l * 1024 * 3072;
    const float* Bv = (sub ? p.in[I_ADA_FFN_B] : p.in[I_ADA_MIX_B]) + (size_t)l * 3072;
    const float* c = p.in[I_C];
    const int j = jc * 64 + lane;
    LAS3 float* ca = (LAS3 float*)lds;
    float acc[32];
#pragma unroll
    for (int b = 0; b < 32; ++b) acc[b] = 0.f;
    for (int k0 = 0; k0 < 1024; k0 += 256) {
#pragma unroll
        for (int i = 0; i < 16; ++i) { const int idx = tid + i * 512, bb = idx & 31, kk = idx >> 5; ca[kk * 32 + bb] = siluf_(c[bb * 1024 + k0 + kk]); }
        __syncthreads();
        for (int kk = 0; kk < 32; ++kk) { const int kl = kg * 32 + kk; const float wv = W[(size_t)(k0 + kl) * 3072 + j];
#pragma unroll
            for (int b4 = 0; b4 < 8; ++b4) { const sc::f32x4 cv = *(const LAS3 sc::f32x4*)(ca + kl * 32 + 4 * b4);
                acc[4 * b4] += cv[0] * wv; acc[4 * b4 + 1] += cv[1] * wv; acc[4 * b4 + 2] += cv[2] * wv; acc[4 * b4 + 3] += cv[3] * wv; } }
        __syncthreads();
    }
    LAS3 float* red = (LAS3 float*)lds;
#pragma unroll
    for (int b = 0; b < 32; ++b) red[(kg * 32 + b) * 64 + lane] = acc[b];
    __syncthreads();
#pragma unroll
    for (int i = 0; i < 4; ++i) { const int o = tid + i * 512, b = o >> 6, cl = o & 63; float sum = 0.f;
#pragma unroll
        for (int g = 0; g < 8; ++g) sum += red[(g * 32 + b) * 64 + cl];
        mod[((size_t)s * 32 + b) * 3072 + jc * 64 + cl] = sum + Bv[jc * 64 + cl]; }
    __syncthreads();
}
constexpr int CVT_LDS = 96 * 1024;
DEVI CvtJob cvt_lookup(const LAS3 unsigned* tb, int gt) {
    int ji = 0;
#pragma unroll
    for (int q = 1; q < N_CVT; ++q) ji = (gt >= (int)tb[q * (int)(sizeof(CvtJob) / 4) + (int)(offsetof(CvtJob, tile0) / 4)]) ? q : ji;
    const LAS3 unsigned* r = tb + ji * (int)(sizeof(CvtJob) / 4);
    CvtJob jb;
    jb.src = (const float*)(((unsigned long long)r[1] << 32) | r[0]); jb.dst = (bf16_t*)(((unsigned long long)r[3] << 32) | r[2]); jb.src_bstride = (long long)(((unsigned long long)r[5] << 32) | r[4]);
    jb.K = (int)r[6]; jb.ncols = (int)r[7]; jb.ldsrc = (int)r[8]; jb.nb = (int)r[9]; jb.dst_rows_per_batch = (int)r[10]; jb.mode = (int)r[11]; jb.tile0 = (int)r[12]; jb.f8 = (int)r[13]; jb.dst_ld = (int)r[14]; jb.pad = ji;
    return jb;
}
DEVI void ph_prologue(const Params& p, LAS3 unsigned char* lds) {
    const int tid = tid_(), half = tid >> 8, t = tid & 255;
    unsigned char* ws = p.ws;
    for (int u = (int)blockIdx.x; u < 192; u += (int)gridDim.x) ada_unit(p, u, lds, (float*)(ws + OFF_MOD));
    if (blockIdx.x == gridDim.x - 1) { const float* lg = p.in[I_LB]; float* lb = (float*)(ws + OFF_LBT); const float z0 = lg[tid], z1 = lg[512 + tid]; lb[tid] = 0.f; lb[512 + tid] = 1.0f / (1.0f + __expf(z0 - z1)); }
    if (MOED_F8) { unsigned char* w2 = (unsigned char*)((bf16_t*)(ws + OFF_WEIGHTS) + WT_M2);
        for (int i = (int)blockIdx.x * 512 + tid; i < 8192 * 8; i += (int)gridDim.x * 512) *(uint4*)(w2 + (size_t)(i >> 3) * KD8 + D_FFE + (i & 7) * 16) = make_uint4(0u, 0u, 0u, 0u); }
    LAS3 float* tile = (LAS3 float*)(lds + half * (64 * MT_PITCH * 4));
    LAS3 unsigned* tb = (LAS3 unsigned*)(lds + CVT_LDS);
    { const unsigned* ka = (const unsigned*)__builtin_amdgcn_kernarg_segment_ptr() + offsetof(Params, J) / 4;
      for (int i = tid; i < (int)(sizeof(CvtJobs) / 4); i += 512) tb[i] = ka[i];
      __syncthreads(); }
    LAS3 float* wql = (LAS3 float*)(lds + CVT_LDS + 2048);
    if (USE_I8) {
        LAS3 float* wpart = wql + N_CVT;
        float ssj[N_I8J];
#pragma unroll
        for (int i = 0; i < N_I8J; ++i) { const LAS3 unsigned* r = tb + i8job(i) * (int)(sizeof(CvtJob) / 4);
            const float* sp = (const float*)(((unsigned long long)r[1] << 32) | r[0]); const int ldsrc = (int)r[8]; float a = 0.f;
#pragma unroll
            for (int q = 0; q < 4; ++q) { const vf4 x = *(const vf4*)(sp + (size_t)((tid >> 5) + 16 * q) * ldsrc + (tid & 31) * 4); a += x[0] * x[0] + x[1] * x[1] + x[2] * x[2] + x[3] * x[3]; }
            ssj[i] = a; }
#pragma unroll
        for (int i = 0; i < N_I8J; ++i) { const float a = wave_sum(ssj[i]); if ((tid & 63) == 0) wpart[i * 8 + (tid >> 6)] = a; }
        __syncthreads();
        if (tid < N_I8J) { float tot = 0.f;
#pragma unroll
            for (int w = 0; w < 8; ++w) tot += wpart[tid * 8 + w];
            const float clip = fmaxf(I8_CLIP * sqrtf(tot * (1.0f / 8192.0f)), 1e-30f);
            wql[i8job(tid)] = 127.0f / clip;
            if (blockIdx.x == 0) ((float*)(ws + OFF_WSTEP))[i8job(tid)] = clip * (1.0f / 127.0f); }
        __syncthreads();
    }
    const int total = (int)tb[N_CVT * (int)(sizeof(CvtJob) / 4)], nh = 2 * (int)gridDim.x, hid = 2 * (int)blockIdx.x + half;
    vf4 ldA[8], ldB[8];
    int mtA = hid, mtB = hid + nh; bool actA = mtA < total, actB = mtB < total; CvtJob jbA = cvt_lookup(tb, mtA), jbB = cvt_lookup(tb, mtB);
    if (actA) cvt_mt_load(jbA, mtA - jbA.tile0, t, ldA);
    if (actB) cvt_mt_load(jbB, mtB - jbB.tile0, t, ldB);
    for (int base = 0; base < total; base += 2 * nh) {
        if (actA) cvt_mt_lds(t, ldA, tile);
        __syncthreads();
        { const int mtn = mtA + 2 * nh; const bool actn = mtn < total; const CvtJob jbn = cvt_lookup(tb, mtn);
          if (actA) cvt_mt_store(jbA, mtA - jbA.tile0, t, tile, wql);
          if (actn) cvt_mt_load(jbn, mtn - jbn.tile0, t, ldA);
          mtA = mtn; actA = actn; jbA = jbn; }
        __syncthreads();
        if (actB) cvt_mt_lds(t, ldB, tile);
        __syncthreads();
        { const int mtn = mtB + 2 * nh; const bool actn = mtn < total; const CvtJob jbn = cvt_lookup(tb, mtn);
          if (actB) cvt_mt_store(jbB, mtB - jbB.tile0, t, tile, wql);
          if (actn) cvt_mt_load(jbn, mtn - jbn.tile0, t, ldB);
          mtB = mtn; actB = actn; jbB = jbn; }
        __syncthreads();
    }
}

constexpr int NORM_LCNT = 8 * 1024 * 4;
constexpr int NORM_VEC = 40 * 1024;
template <int MODE, int FMT, bool XF32>
DEVI void ph_norm(LAS3 unsigned char* lds, const void* __restrict__ x, const float* __restrict__ g, const float* __restrict__ mod, bf16_t* __restrict__ H, const float* __restrict__ wext, const float* __restrict__ rbias,
                  float* __restrict__ gates_out, int* __restrict__ ridx, float* __restrict__ rgate, int* __restrict__ rrank, int* __restrict__ cnt, int* __restrict__ wgbase, float* __restrict__ rs_out = nullptr) {
    constexpr bool F8 = (FMT == 1);
    const int lane = tid_() & 63, wave = __builtin_amdgcn_readfirstlane(tid_() >> 6);
    constexpr int LD = (MODE == 0) ? IN_COLS : 8;
    LAS3 int* lcnt = (LAS3 int*)(lds + NORM_LCNT);
    sc::f32x4 wr[16][2];
    if (MODE != 1) {
#pragma unroll
        for (int i = 0; i < 4; ++i)
#pragma unroll
            for (int j = 0; j < 4; ++j) { const int col = XF32 ? (lane + 64 * i) * 4 + j : (lane + 64 * (i >> 1)) * 8 + 4 * (i & 1) + j; const sc::f32x4* wp = (const sc::f32x4*)(wext + (size_t)col * LD); wr[4 * i + j][0] = wp[0]; wr[4 * i + j][1] = wp[1]; }
        if (MODE == 2 && tid_() < 8) lcnt[tid_()] = 0;
        __syncthreads();
    }
    LAS3 float* gmv = (LAS3 float*)(lds + NORM_VEC); LAS3 float* shv = gmv + 1024;
    for (int pm = (int)blockIdx.x; pm < TOK / 256; pm += (int)gridDim.x) {
      { const int b = pm >> 3; const float* mb = mod + (size_t)b * 3072;
        for (int k = tid_(); k < 1024; k += 512) { gmv[k] = g[k] * (1.f + mb[1024 + k]); shv[k] = mb[k]; }
        __syncthreads(); }
      int cols[4];
#pragma unroll
      for (int i = 0; i < 4; ++i) cols[i] = XF32 ? (lane + 64 * i) * 4 : (lane + 64 * (i >> 1)) * 8 + 4 * (i & 1);
      float4 nf[4]; uint4 nw[2];
      { const int row = pm * 256 + wave;
        if (XF32) { const float4* xr = (const float4*)((const float*)x + (size_t)row * 1024);
#pragma unroll
            for (int i = 0; i < 4; ++i) nf[i] = xr[lane + 64 * i]; }
        else { const uint4* xr = (const uint4*)((const bf16_t*)x + (size_t)row * 1024);
#pragma unroll
            for (int i = 0; i < 2; ++i) nw[i] = xr[lane + 64 * i]; } }
      for (int rr = wave; rr < 256; rr += 8) {
        const int row = pm * 256 + rr;
        float4 v[4]; float ss = 0.f;
        if (XF32) {
#pragma unroll
            for (int i = 0; i < 4; ++i) v[i] = nf[i]; }
        else {
#pragma unroll
            for (int i = 0; i < 2; ++i) { const uint4 w = nw[i];
                v[2 * i] = make_float4(__uint_as_float(w.x << 16), __uint_as_float(w.x & 0xffff0000u), __uint_as_float(w.y << 16), __uint_as_float(w.y & 0xffff0000u));
                v[2 * i + 1] = make_float4(__uint_as_float(w.z << 16), __uint_as_float(w.z & 0xffff0000u), __uint_as_float(w.w << 16), __uint_as_float(w.w & 0xffff0000u)); } }
        if (rr + 8 < 256) {
            if (XF32) { const float4* xr = (const float4*)((const float*)x + (size_t)(row + 8) * 1024);
#pragma unroll
                for (int i = 0; i < 4; ++i) nf[i] = xr[lane + 64 * i]; }
            else { const uint4* xr = (const uint4*)((const bf16_t*)x + (size_t)(row + 8) * 1024);
#pragma unroll
                for (int i = 0; i < 2; ++i) nw[i] = xr[lane + 64 * i]; } }
#pragma unroll
        for (int i = 0; i < 4; ++i) ss += v[i].x * v[i].x + v[i].y * v[i].y + v[i].z * v[i].z + v[i].w * v[i].w;
        ss = wave_sum(ss);
        const float rstd = rsqrtf(ss * (1.0f / 1024.0f) + EPS);
        typedef float f32x2_t __attribute__((ext_vector_type(2)));
        f32x2_t ext2[4];
#pragma unroll
        for (int e = 0; e < 4; ++e) ext2[e] = (f32x2_t){0.f, 0.f};
        float hq[4][4]; float amax = 0.f;
#pragma unroll
        for (int i = 0; i < 4; ++i) {
            const int col = cols[i];
            const sc::f32x4 gm = *(const LAS3 sc::f32x4*)(gmv + col), sh = *(const LAS3 sc::f32x4*)(shv + col);
            float hv[4];
            hv[0] = v[i].x * rstd * gm[0] + sh[0]; hv[1] = v[i].y * rstd * gm[1] + sh[1];
            hv[2] = v[i].z * rstd * gm[2] + sh[2]; hv[3] = v[i].w * rstd * gm[3] + sh[3];
            if (FMT == 2) {
#pragma unroll
                for (int j = 0; j < 4; ++j) { hq[i][j] = hv[j]; amax = fmaxf(amax, fabsf(hv[j])); } }
            else if (F8) { unsigned q8 = 0u; q8 = __builtin_amdgcn_cvt_pk_fp8_f32(sat8(hv[0]), sat8(hv[1]), q8, false); q8 = __builtin_amdgcn_cvt_pk_fp8_f32(sat8(hv[2]), sat8(hv[3]), q8, true);
                *(unsigned*)((unsigned char*)H + (size_t)row * 1024 + col) = q8; }
            else { uint2 pk; pk.x = cvt2bf(hv[0], hv[1]); pk.y = cvt2bf(hv[2], hv[3]);
            *(uint2*)(H + (size_t)row * 1024 + col) = pk; }
            if (MODE != 1) {
#pragma unroll
                for (int j = 0; j < 4; ++j) { const f32x2_t hh = (f32x2_t){hv[j], hv[j]};
#pragma unroll
                    for (int q = 0; q < 2; ++q) { const sc::f32x4 w = wr[4 * i + j][q];
                        ext2[2 * q] = __builtin_elementwise_fma(hh, (f32x2_t){w[0], w[1]}, ext2[2 * q]); ext2[2 * q + 1] = __builtin_elementwise_fma(hh, (f32x2_t){w[2], w[3]}, ext2[2 * q + 1]); } }
            }
        }
        if (FMT == 2) {
            amax = fmaxf(wave_max(amax), 1e-30f);
            const float inv = 127.0f / amax;
#pragma unroll
            for (int i = 0; i < 4; ++i) *(unsigned*)((unsigned char*)H + (size_t)row * 1024 + cols[i]) = pack_i8x4(hq[i][0] * inv, hq[i][1] * inv, hq[i][2] * inv, hq[i][3] * inv);
            if (lane == 0) rs_out[row] = amax * (1.0f / 127.0f);
        }
        if (MODE != 1) {
            float ext[8];
            { float xs[8];
#pragma unroll
              for (int e = 0; e < 8; ++e) xs[e] = ext2[e >> 1][e & 1];
              const float tot = wave_sum8(xs, lane);
#pragma unroll
              for (int e = 0; e < 8; ++e) ext[e] = __int_as_float(__builtin_amdgcn_readlane(__float_as_int(tot), e)); }
            if (MODE == 0) { if (lane == 0) { *(float4*)(gates_out + (size_t)row * 8) = make_float4(ext[0], ext[1], ext[2], ext[3]); *(float4*)(gates_out + (size_t)row * 8 + 4) = make_float4(ext[4], ext[5], ext[6], ext[7]); } }
            else {
                float best = -3.0e38f, second = -3.0e38f; int bi = 0, si = 0;
#pragma unroll
                for (int e = 0; e < 8; ++e) { const float lv = ext[e] + rbias[e];
                    if (lv > best) { second = best; si = bi; best = lv; bi = e; } else if (lv > second) { second = lv; si = e; } }
                if (lane == 0) {
                    const float e1 = __expf(second - best), g0 = 1.0f / (1.0f + e1), g1 = e1 / (1.0f + e1);
                    ridx[row * 2] = bi; ridx[row * 2 + 1] = si; rgate[row * 2] = g0; rgate[row * 2 + 1] = g1;
                    rrank[row * 2] = atomicAdd((int*)(lcnt + bi), 1); rrank[row * 2 + 1] = atomicAdd((int*)(lcnt + si), 1);
                }
            }
        }
      }
      __syncthreads();
    }
    if (MODE == 2) {
        __syncthreads();
        if (tid_() < 8) wgbase[(int)blockIdx.x * 8 + tid_()] = atomicAdd(&cnt[tid_()], lcnt[tid_()]);
    }
}

struct MoeBases { int b[9]; };
DEVI MoeBases moe_bases(const int* __restrict__ cnt) {
    MoeBases m; int acc = 0;
#pragma unroll
    for (int e = 0; e < 8; ++e) { m.b[e] = acc; acc += (__builtin_amdgcn_readfirstlane(cnt[e]) + 255) & ~255; }
    m.b[8] = acc; return m;
}
namespace pg8 {
struct MoeOrder2 {
    MoeBases mb; int nN, G, c;
    __device__ bool next(int i, Unit& u) const {
        const int nt = mb.b[8] >> 8; const long L = (long)i * G + c; if (L >= (long)nt * nN) return false;
        const int pm = (int)(L / nN), pnl = (int)(L % nN), row = pm * 256; int e = 0;
#pragma unroll
        for (int q = 1; q < 8; ++q) e += (row >= mb.b[q]) ? 1 : 0;
        u.pm = pm; u.pn = e * nN + pnl; u.acol = 0; return true;
    }
};
}
DEVI void ph_gather(const bf16_t* __restrict__ H, const int* __restrict__ ridx, const int* __restrict__ rrank, const int* __restrict__ wgbase, const MoeBases& mb, int* __restrict__ rpos, bf16_t* __restrict__ A2, const float* __restrict__ rsH, float* __restrict__ rsE) {
    const int lane = tid_() & 63, wave = __builtin_amdgcn_readfirstlane(tid_() >> 6);
    constexpr bool B1 = (MOE_F8 || USE_I8);
    for (int t0 = 4 * ((int)blockIdx.x * 8 + wave); t0 < TOK; t0 += 4 * (int)gridDim.x * 8) {
        uint4 r0[4], r1[4];
#pragma unroll
        for (int i = 0; i < 4; ++i) {
            if (B1) r0[i] = ((const uint4*)((const unsigned char*)H + (size_t)(t0 + i) * 1024))[lane];
            else { const uint4* src = (const uint4*)(H + (size_t)(t0 + i) * 1024); r0[i] = src[lane]; r1[i] = src[lane + 64]; } }
        int pz = 0;
        if (lane < 8) { const int w = 2 * t0 + lane, t = w >> 1; const int e = ridx[w]; int base = 0;
#pragma unroll
            for (int q = 1; q < 8; ++q) base = (e == q) ? mb.b[q] : base;
            pz = base + wgbase[((t >> 8) % (int)gridDim.x) * 8 + e] + rrank[w];
            rpos[w] = pz; if (USE_I8) rsE[pz] = rsH[t]; }
#pragma unroll
        for (int j = 0; j < 8; ++j) { const int pj = __builtin_amdgcn_readlane(pz, j);
            if (B1) ((uint4*)((unsigned char*)A2 + (size_t)pj * 1024))[lane] = r0[j >> 1];
            else { uint4* dst = (uint4*)(A2 + (size_t)pj * 1024); dst[lane] = r0[j >> 1]; dst[lane + 64] = r1[j >> 1]; } }
    }
}
DEVI void ph_final(LAS3 unsigned char* lds, const bf16_t* __restrict__ x, const float* __restrict__ mod, const bf16_t* __restrict__ YE, const int* __restrict__ rpos, const float* __restrict__ rgate, const float* __restrict__ fg, float* out) {
    const int lane = tid_() & 63, wave = __builtin_amdgcn_readfirstlane(tid_() >> 6);
    LAS3 float* gtv = (LAS3 float*)lds; LAS3 float* fgv = gtv + 1024;
    for (int pm = (int)blockIdx.x; pm < TOK / 256; pm += (int)gridDim.x) {
      { const float* mb = mod + (size_t)(pm >> 3) * 3072 + 2048;
        for (int k = tid_(); k < 1024; k += 512) { gtv[k] = mb[k]; fgv[k] = fg[k]; }
        __syncthreads(); }
      for (int rr = wave; rr < 256; rr += 8) {
        const int row = pm * 256 + rr;
        const int p0 = rpos[row * 2], p1 = rpos[row * 2 + 1]; const float g0 = rgate[row * 2], g1 = rgate[row * 2 + 1];
        float4 v[4]; float ss = 0.f;
#pragma unroll
        for (int i = 0; i < 4; ++i) {
            const int col = (lane + 64 * i) * 4;
            const uint2 xw = *(const uint2*)(x + (size_t)row * 1024 + col);
            const float4 xv = make_float4(__uint_as_float(xw.x << 16), __uint_as_float(xw.x & 0xffff0000u), __uint_as_float(xw.y << 16), __uint_as_float(xw.y & 0xffff0000u));
            const sc::f32x4 gt = *(const LAS3 sc::f32x4*)(gtv + col);
            const uint2 y0 = *(const uint2*)(YE + (size_t)p0 * 1024 + col), y1 = *(const uint2*)(YE + (size_t)p1 * 1024 + col);
            v[i].x = xv.x + gt[0] * (g0 * __uint_as_float(y0.x << 16) + g1 * __uint_as_float(y1.x << 16));
            v[i].y = xv.y + gt[1] * (g0 * __uint_as_float(y0.x & 0xffff0000u) + g1 * __uint_as_float(y1.x & 0xffff0000u));
            v[i].z = xv.z + gt[2] * (g0 * __uint_as_float(y0.y << 16) + g1 * __uint_as_float(y1.y << 16));
            v[i].w = xv.w + gt[3] * (g0 * __uint_as_float(y0.y & 0xffff0000u) + g1 * __uint_as_float(y1.y & 0xffff0000u));
            ss += v[i].x * v[i].x + v[i].y * v[i].y + v[i].z * v[i].z + v[i].w * v[i].w;
        }
        ss = wave_sum(ss);
        const float rstd = rsqrtf(ss * (1.0f / 1024.0f) + EPS);
#pragma unroll
        for (int i = 0; i < 4; ++i) { const int col = (lane + 64 * i) * 4; const sc::f32x4 gg = *(const LAS3 sc::f32x4*)(fgv + col);
            *(float4*)(out + (size_t)row * 1024 + col) = make_float4(v[i].x * rstd * gg[0], v[i].y * rstd * gg[1], v[i].z * rstd * gg[2], v[i].w * rstd * gg[3]); }
      }
      __syncthreads();
    }
}

constexpr int N_PHASES = 22;
#define IN_PH(k) (ph_lo <= (k) && (k) < ph_hi)
#define SEAM(k) do { if ((k) + 1 < ph_hi) { XcdBarrier b_; b_.bar = (unsigned*)(p.ws + OFF_BAR); b_.x = xb_xcc_id(); b_.st = (volatile LAS unsigned*)(lds + LDSCTL); xcd_barrier(b_); } } while (0)
#define WSP(T, off) ((T*)(ws + (off)))
template <int l>
DEVI void layer_phases(const Params& p, LAS3 unsigned char* lds, const XcdBarrier& bar, int ph_lo, int ph_hi) {
    unsigned char* ws = p.ws;
    constexpr int pb = 1 + 10 * l;
    const int G = (int)gridDim.x, cid = (int)blockIdx.x;
    constexpr int WFMT = USE_I8 ? 2 : ((l == 1 && WIN1_F8 != 0) ? 1 : 0);
    if (IN_PH(pb + 0)) { ph_norm<0, WFMT, (l == 0)>(lds, (l == 0) ? (const void*)p.in[I_X] : (const void*)WSP(bf16_t, OFF_XB), p.in[I_NORM_MIX_G] + l * 1024, WSP(float, OFF_MOD) + (size_t)(2 * l) * 32 * 3072, WSP(bf16_t, OFF_H), p.in[I_W_IN] + (size_t)l * 1024 * IN_COLS + 3584, nullptr,
                                    WSP(float, OFF_GATES), nullptr, nullptr, nullptr, nullptr, nullptr, WSP(float, OFF_RSH)); SEAM(pb + 0); }
    constexpr bool W8 = (WFMT != 0);
    if (IN_PH(pb + 1)) { pg8::Gemm g{WSP(bf16_t, OFF_H), WSP(bf16_t, OFF_WEIGHTS) + WT_IN + (size_t)l * 5632 * 1024, W8 ? 512 : 1024, W8 ? 512 : 1024, WSP(float, OFF_RSH), WSP(float, OFF_WSTEP) + 3 * l, WSP(float, OFF_WSTEP) + 3 * l}; pg8::StaticOrder S; S.init(TOK, 3584, G, cid);
        pg8::FEpiWinA e{WSP(bf16_t, OFF_QM), WSP(float, OFF_LF), WSP(bf16_t, OFF_HI), WSP(bf16_t, OFF_HG), WSP(bf16_t, OFF_MU), WSP(bf16_t, OFF_MV), WSP(float, OFF_LBT) + l * 512, WFMT == 1 ? 1.0f / (float)(1 << W13_F8) : 1.0f};
        pg8::gemm_phase<pg8::FEpiWinA, pg8::StaticOrder, WFMT>(lds, g, S, e); SEAM(pb + 1); }
    if (IN_PH(pb + 2)) {
        sc::ScanArgs sa{WSP(bf16_t, OFF_QM), WSP(bf16_t, OFF_QM), WSP(float, OFF_LF), WSP(bf16_t, OFF_HI), WSP(bf16_t, OFF_HG), WSP(bf16_t, OFF_MU), WSP(bf16_t, OFF_MV), WSP(float, OFF_GATES),
                        p.in[I_HG_NORM] + l * 512, p.in[I_ML_NORM] + l * 512, p.in[I_CONV_W] + l * 4 * 512, p.in[I_CONV_B] + l * 512,
                        p.in[I_WQ] + (size_t)l * 4 * 128 * 64, p.in[I_WK] + (size_t)l * 4 * 128 * 64, p.in[I_FBIAS] + l * 4, nullptr};
        for (int it = cid; it < 256; it += G) { sc::scan_item(lds, sa, it); __syncthreads(); }
        SEAM(pb + 2); }
    if (IN_PH(pb + 3)) { pg8::Gemm g{WSP(bf16_t, OFF_H), WSP(bf16_t, OFF_WEIGHTS) + WT_IN + (size_t)l * 5632 * 1024 + (W8 ? 3584ull * 512 : 3584ull * 1024), W8 ? 512 : 1024, W8 ? 512 : 1024, WSP(float, OFF_RSH), WSP(float, OFF_WSTEP) + 3 * l + 1, WSP(float, OFF_WSTEP) + 3 * l + 2}; pg8::StaticOrder S; S.init(TOK, 2048, G, cid);
        pg8::FEpiWinG e{WSP(bf16_t, OFF_GA), WSP(bf16_t, OFF_GB), WFMT == 1 ? 1.0f / (float)(1 << W13_F8) : 1.0f};
        pg8::gemm_phase<pg8::FEpiWinG, pg8::StaticOrder, WFMT>(lds, g, S, e); SEAM(pb + 3); }
    if (IN_PH(pb + 4)) {
        pg8::Gemm g{WSP(bf16_t, OFF_QM), WSP(bf16_t, OFF_WEIGHTS) + WT_BRH + (size_t)l * 1024 * (BR_F8 ? 256 : 512), BR_F8 ? 256 : 512, 1024, nullptr, nullptr, nullptr, BR_F8 ? 256u : 0u}; pg8::BrOrder S; S.init(TOK, 1024, G, cid);
        pg8::FEpiBrG e{WSP(bf16_t, OFF_GA), WSP(bf16_t, OFF_GB), WSP(bf16_t, OFF_MERGED), OUT_F8 != 0, (OUT_F8 ? (float)(1 << OUT_A_SH) : 1.0f) * (BR_F8 ? 1.0f / (float)(1 << (BR_A_SH + W13_F8)) : 1.0f)};
        pg8::gemm_phase<pg8::FEpiBrG, pg8::BrOrder, BR_F8 != 0>(lds, g, S, e);
        SEAM(pb + 4); }
    if (IN_PH(pb + 5)) { pg8::Gemm g{WSP(bf16_t, OFF_MERGED), WSP(bf16_t, OFF_WEIGHTS) + WT_OUT + (size_t)l * 1024 * (OUT_F8 ? 512 : 1024), OUT_F8 ? 512 : 1024, OUT_F8 ? 512 : 1024}; pg8::StaticOrder S; S.init(TOK, 1024, G, cid);
        pg8::FEpiResidT<(l == 0)> e{(l == 0) ? (const void*)p.in[I_X] : (const void*)WSP(bf16_t, OFF_XB), WSP(bf16_t, OFF_XB), WSP(float, OFF_MOD) + (size_t)(2 * l) * 32 * 3072, OUT_F8 ? 1.0f / (float)(1 << (W13_F8 + OUT_A_SH)) : 1.0f};
        pg8::gemm_phase<pg8::FEpiResidT<(l == 0)>, pg8::StaticOrder, OUT_F8 != 0>(lds, g, S, e); SEAM(pb + 5); }
    if (l == 0) {
        constexpr int DFMT = USE_I8 ? 2 : (DENSE_F8 ? 1 : 0);
        if (IN_PH(pb + 6)) { ph_norm<1, DFMT, false>(lds, WSP(bf16_t, OFF_XB), p.in[I_NORM_FFN_G] + l * 1024, WSP(float, OFF_MOD) + (size_t)(2 * l + 1) * 32 * 3072, WSP(bf16_t, OFF_H), nullptr, nullptr, nullptr, nullptr, nullptr, nullptr, nullptr, nullptr, WSP(float, OFF_RSH)); SEAM(pb + 6); }
        if (IN_PH(pb + 7)) { pg8::Gemm g{WSP(bf16_t, OFF_H), WSP(bf16_t, OFF_WEIGHTS) + WT_F13, DFMT ? 512 : 1024, DFMT ? 512 : 1024, WSP(float, OFF_RSH), WSP(float, OFF_WSTEP) + 9, WSP(float, OFF_WSTEP) + 10}; pg8::StaticOrder S; S.init(TOK, 5632, G, cid); pg8::FEpiSwigluT<DENSED_F8 != 0> e{WSP(bf16_t, OFF_U), D_FF, 22, DFMT == 1 ? 1.0f / (float)(1 << W13_F8) : 1.0f, 0};
            pg8::gemm_phase<pg8::FEpiSwigluT<DENSED_F8 != 0>, pg8::StaticOrder, DFMT>(lds, g, S, e); SEAM(pb + 7); }
        if (IN_PH(pb + 8)) { pg8::Gemm g{WSP(bf16_t, OFF_U), WSP(bf16_t, OFF_WEIGHTS) + WT_F2, DENSED_F8 ? D_FF / 2 : D_FF, DENSED_F8 ? D_FF / 2 : D_FF}; pg8::StaticOrder S; S.init(TOK, 1024, G, cid);
            pg8::FEpiResidT<false> e{WSP(bf16_t, OFF_XB), WSP(bf16_t, OFF_XB), WSP(float, OFF_MOD) + (size_t)(2 * l + 1) * 32 * 3072, DENSED_F8 ? 1.0f / (float)(1 << W2_F8) : 1.0f};
            pg8::gemm_phase<pg8::FEpiResidT<false>, pg8::StaticOrder, DENSED_F8 != 0>(lds, g, S, e); SEAM(pb + 8); }
        if (IN_PH(pb + 9)) { SEAM(pb + 9); }
    } else {
        constexpr int MFMT = USE_I8 ? 2 : (MOE_F8 ? 1 : 0);
        if (IN_PH(pb + 6)) { ph_norm<2, MFMT, false>(lds, WSP(bf16_t, OFF_XB), p.in[I_NORM_FFN_G] + l * 1024, WSP(float, OFF_MOD) + (size_t)(2 * l + 1) * 32 * 3072, WSP(bf16_t, OFF_H), p.in[I_RW], p.in[I_RB], nullptr,
                                        WSP(int, OFF_RIDX), WSP(float, OFF_RGATE), WSP(int, OFF_RRANK), WSP(int, OFF_MOECNT), WSP(int, OFF_MOECTL) + 1024, WSP(float, OFF_RSH)); SEAM(pb + 6); }
        if (IN_PH(pb + 7)) { const MoeBases mb = moe_bases(WSP(int, OFF_MOECNT)); ph_gather(WSP(bf16_t, OFF_H), WSP(int, OFF_RIDX), WSP(int, OFF_RRANK), WSP(int, OFF_MOECTL) + 1024, mb, WSP(int, OFF_RPOS), WSP(bf16_t, OFF_A2), WSP(float, OFF_RSH), WSP(float, OFF_RSE)); SEAM(pb + 7); }
        if (IN_PH(pb + 8)) { const MoeBases mb = moe_bases(WSP(int, OFF_MOECNT)); pg8::Gemm g{WSP(bf16_t, OFF_A2), WSP(bf16_t, OFF_WEIGHTS) + WT_M13, MFMT ? 512 : 1024, MFMT ? 512 : 1024, WSP(float, OFF_RSE), WSP(float, OFF_WSTEP) + 12, WSP(float, OFF_WSTEP) + 13}; pg8::MoeOrder2 S{mb, 11, G, cid}; pg8::FEpiSwigluT<MOED_F8 != 0> e{WSP(bf16_t, OFF_UE), MOED_F8 ? KD8 : D_FFE, 11, MFMT == 1 ? 1.0f / (float)(1 << W13_F8) : 1.0f, 1};
            pg8::gemm_phase<pg8::FEpiSwigluT<MOED_F8 != 0>, pg8::MoeOrder2, MFMT>(lds, g, S, e); SEAM(pb + 8); }
        if (IN_PH(pb + 9)) { const MoeBases mb = moe_bases(WSP(int, OFF_MOECNT)); pg8::Gemm g{WSP(bf16_t, OFF_UE), WSP(bf16_t, OFF_WEIGHTS) + WT_M2, MOED_F8 ? KD8 / 2 : D_FFE, MOED_F8 ? KD8 / 2 : D_FFE}; pg8::MoeOrder2 S{mb, 4, G, cid}; pg8::FEpiStoreBf e{WSP(bf16_t, OFF_A2), 1024, 4, MOED_F8 ? 1.0f / (float)(1 << W2_F8) : 1.0f};
            pg8::gemm_phase<pg8::FEpiStoreBf, pg8::MoeOrder2, MOED_F8 != 0>(lds, g, S, e); SEAM(pb + 9); }
    }
}
__global__ void __launch_bounds__(512, 2) k_mega(Params p, int ph_lo, int ph_hi) {
    LAS3 unsigned char* lds = (LAS3 unsigned char*)g_shm;
    if ((threadIdx.x & 63) == 0) ((LAS3 int*)(lds + LDS_WAVETAB))[hw_wave_key()] = (int)(threadIdx.x >> 6);
    unsigned char* ws = p.ws;
    if (threadIdx.x < 4) ((LAS3 unsigned*)(lds + LDSCTL))[threadIdx.x] = 0u;
    __syncthreads();
    XcdBarrier bar; bar.bar = (unsigned*)(ws + OFF_BAR); bar.x = 0; bar.st = nullptr;
    if (ph_hi - ph_lo > 1) bar = xcd_barrier_post((unsigned*)(ws + OFF_BAR), (volatile LAS unsigned*)(lds + LDSCTL));
    if (IN_PH(0)) { ph_prologue(p, lds); SEAM(0); }
    layer_phases<0>(p, lds, bar, ph_lo, ph_hi);
    layer_phases<1>(p, lds, bar, ph_lo, ph_hi);
    if (IN_PH(21)) ph_final(lds, WSP(bf16_t, OFF_XB), WSP(float, OFF_MOD) + (size_t)3 * 32 * 3072, WSP(bf16_t, OFF_A2), WSP(int, OFF_RPOS), WSP(float, OFF_RGATE), p.in[I_FINAL_G], p.out);
}
#undef IN_PH
#undef SEAM

#ifndef MK_PER_PHASE
#define MK_PER_PHASE 0
#endif
extern "C" void kernel_launch(void* const* d_in, const int* in_sizes, int n_in, void* d_out, int out_size, void* d_ws, size_t ws_size, hipStream_t stream) {
    (void)in_sizes; (void)out_size; (void)ws_size;
    static int grid = 0;
    if (grid == 0) {
        int dev = 0, cus = 0, per_cu = 0;
        (void)hipGetDevice(&dev); (void)hipDeviceGetAttribute(&cus, hipDeviceAttributeMultiprocessorCount, dev);
        (void)hipFuncSetAttribute((const void*)k_mega, hipFuncAttributeMaxDynamicSharedMemorySize, LDS_BYTES);
        (void)hipOccupancyMaxActiveBlocksPerMultiprocessor(&per_cu, (const void*)k_mega, 512, LDS_BYTES);
        (void)hipGetLastError();
        grid = (cus > 0 && cus < 256) ? cus : 256;
        if (per_cu < 1) grid = 256;
    }
    char* ws = (char*)d_ws;
    (void)hipMemsetAsync(ws + OFF_CTR, 0, 4096 + XCD_BAR_WORDS * 4, stream);
    Params p; memset(&p, 0, sizeof(p));
    for (int i = 0; i < N_IN && i < n_in; ++i) p.in[i] = (const float*)d_in[i];
    p.out = (float*)d_out; p.ws = (unsigned char*)d_ws;
    {
        bf16_t* WT = (bf16_t*)(ws + OFF_WEIGHTS);
        CvtJobs& J = p.J; int nj = 0, tiles = 0;
        auto add = [&](const float* src, bf16_t* dst, int K, int ncols, int ldsrc, int nb, long long sb, int drpb, int mode, int f8 = 0, int dst_ld = 0) {
            CvtJob& q = J.j[nj++]; q.src = src; q.dst = dst; q.K = K; q.ncols = ncols; q.ldsrc = ldsrc; q.nb = nb; q.src_bstride = sb; q.dst_rows_per_batch = drpb; q.mode = mode; q.f8 = f8; q.dst_ld = dst_ld ? dst_ld : K; q.pad = 0; q.tile0 = tiles; tiles += nb * (K / 64) * (ncols / 128); };
        for (int l = 0; l < 2; ++l) {
            const int f = USE_I8 ? I8_FLAG : ((l == 1 && WIN1_F8) ? W13_F8 : 0);
            const float* w = p.in[I_W_IN] + (size_t)l * 1024 * IN_COLS; bf16_t* d = WT + WT_IN + (size_t)l * 5632 * 1024;
            bf16_t* dg = f ? (bf16_t*)((unsigned char*)d + 3584ull * 1024) : d + 3584ull * 1024;
            add(w, d, 1024, 3584, IN_COLS, 1, 0, 0, 0, f);
            add(w + 3592, dg, 1024, 1024, IN_COLS, 1, 0, 0, 1, f);
            add(w + 3592 + 1024, dg, 1024, 1024, IN_COLS, 1, 0, 0, 2, f);
        }
        add(p.in[I_BRH], WT + WT_BRH, 512, 1024, 1024, 2, 512ll * 1024, 1024, 0, BR_F8 ? W13_F8 : 0);
        add(p.in[I_BRM], BR_F8 ? (bf16_t*)((unsigned char*)(WT + WT_BRH) + 2048ull * 512) : WT + WT_BRM, 512, 1024, 1024, 2, 512ll * 1024, 1024, 0, BR_F8 ? W13_F8 : 0);
        add(p.in[I_WOUT], WT + WT_OUT, 1024, 1024, 1024, 2, 1024ll * 1024, 1024, 0, OUT_F8 ? W13_F8 : 0);
        add(p.in[I_FW1], WT + WT_F13, 1024, D_FF, D_FF, 1, 0, 0, 1, USE_I8 ? I8_FLAG : (DENSE_F8 ? W13_F8 : 0));
        add(p.in[I_FW3], WT + WT_F13, 1024, D_FF, D_FF, 1, 0, 0, 2, USE_I8 ? I8_FLAG : (DENSE_F8 ? W13_F8 : 0));
        add(p.in[I_FW2], WT + WT_F2, D_FF, 1024, 1024, 1, 0, 0, 0, DENSED_F8 ? W2_F8 : 0);
        add(p.in[I_MW1], WT + WT_M13, 1024, D_FFE, D_FFE, 8, 1024ll * D_FFE, 2816, 1, USE_I8 ? I8_FLAG : (MOE_F8 ? W13_F8 : 0));
        add(p.in[I_MW3], WT + WT_M13, 1024, D_FFE, D_FFE, 8, 1024ll * D_FFE, 2816, 2, USE_I8 ? I8_FLAG : (MOE_F8 ? W13_F8 : 0));
        add(p.in[I_MW2], WT + WT_M2, D_FFE, 1024, 1024, 8, (long long)D_FFE * 1024, 1024, 0, MOED_F8 ? W2_F8 : 0, MOED_F8 ? KD8 : 0);
        for (int q = nj; q < N_CVT; ++q) { J.j[q] = J.j[nj - 1]; J.j[q].tile0 = 0x7fffffff; }
        J.total_tiles = tiles;
    }
    if (MK_PER_PHASE) { for (int ph = 0; ph < N_PHASES; ++ph) hipLaunchKernelGGL(k_mega, dim3(grid), dim3(512), LDS_BYTES, stream, p, ph, ph + 1); }
    else hipLaunchKernelGGL(k_mega, dim3(grid), dim3(512), LDS_BYTES, stream, p, 0, N_PHASES);
}
```
